# Optimizing an MI355X kernel written in HIP

```python
import math
import jax
import jax.numpy as jnp
from jax import lax
import numpy as np


D_MODEL = 1024
BATCH = 8
SEQ = 2048
DEPTH = 4

HEAD_DIM = 128
MIX = D_MODEL // 2
GM_CHUNK = 128
GM_HEADS = MIX // HEAD_DIM
S5_GROUP = 16
S5_GROUPS = MIX // S5_GROUP
S5_STATE = 64
S5_DT_MIN = 1e-3
S5_DT_MAX = 1e-1
ML_HEADS = MIX // HEAD_DIM
ML_CHUNK = 128
CONV_W = 4
MB_HEADS = MIX // HEAD_DIM
MB_BLOCK = 256
MB_TOPK = 3
MB_QBLOCK = 16
ROPE_THETA = 10000.0
N_MEM = 256
XA_HEADS = 4
XA_HEAD_DIM = D_MODEL // XA_HEADS
XA_DIM = XA_HEADS * XA_HEAD_DIM
N_GROUPS = 4
EXP_PER_GROUP = 4
N_EXPERTS = N_GROUPS * EXP_PER_GROUP
EXP_FF = D_MODEL // 4
EXP_TOPK = 2
EPS = 1e-6
N_EVEN = (DEPTH + 1) // 2
N_ODD = DEPTH // 2
EVEN_IN = 3 * MIX
ODD_IN = 7 * MIX + 2 * ML_HEADS

kernel_name = 'hybrid_gmlp_s5_mlstm_moba_hmoe'


def rmsnorm(x, g):
    xf = x.astype(jnp.float32)
    y = xf * lax.rsqrt(jnp.mean(xf * xf, axis=-1, keepdims=True) + EPS)
    return (y * g.astype(jnp.float32)).astype(x.dtype)


def layernorm(x, g):
    xf = x.astype(jnp.float32)
    xc = xf - jnp.mean(xf, axis=-1, keepdims=True)
    y = xc * lax.rsqrt(jnp.mean(xc * xc, axis=-1, keepdims=True) + EPS)
    return (y * g.astype(jnp.float32)).astype(x.dtype)


def split_heads(t, n_heads):
    b, s, w = t.shape
    return t.reshape(b, s, n_heads, w // n_heads).transpose(0, 2, 1, 3)


def merge_heads(t):
    b, h, s, d = t.shape
    return t.transpose(0, 2, 1, 3).reshape(b, s, h * d)


def rope(x):
    s, d = x.shape[-2], x.shape[-1]
    half = d // 2
    inv_freq = ROPE_THETA ** (-jnp.arange(half, dtype=jnp.float32) / half)
    ang = jnp.arange(s, dtype=jnp.float32)[:, None] * inv_freq[None, :]
    cos, sin = jnp.cos(ang), jnp.sin(ang)
    xf = x.astype(jnp.float32)
    x1, x2 = xf[..., :half], xf[..., half:]
    return jnp.concatenate([x1 * cos - x2 * sin, x1 * sin + x2 * cos], axis=-1).astype(x.dtype)


def gmlp_mixer(u, v, ws, bs, ln_g):
    b, s, _ = u.shape
    nc = s // GM_CHUNK
    vh = layernorm(v.reshape(b, s, GM_HEADS, HEAD_DIM), ln_g.reshape(GM_HEADS, HEAD_DIM))
    vh = vh.reshape(b, nc, GM_CHUNK, GM_HEADS, HEAD_DIM)
    causal = jnp.tril(jnp.ones((GM_CHUNK, GM_CHUNK), dtype=bool))
    w = jnp.where(causal[None], ws, jnp.zeros_like(ws))
    mixed = jnp.einsum('hts,bcshd->bcthd', w, vh) + bs.T[None, None, :, :, None]
    return u * mixed.reshape(b, s, MIX).astype(u.dtype)


def _linear_combine(e1, e2):
    a1, b1 = e1
    a2, b2 = e2
    return a1 * a2, a2 * b1 + b2


def s5_mixer(u, lam_re, lam_im, b_re, b_im, c_re, c_im, d_skip, log_step, w_glu, b_glu):
    f32 = jnp.float32
    bsz, s, _ = u.shape
    uf = u.astype(f32).reshape(bsz, s, S5_GROUPS, S5_GROUP)
    lam = lax.complex(lam_re.astype(f32), lam_im.astype(f32))
    step = jnp.exp(log_step.astype(f32))[:, None]
    lam_bar = jnp.exp(lam * step)
    b_mat = lax.complex(b_re.astype(f32), b_im.astype(f32))
    b_bar = ((lam_bar - 1.0) / lam)[..., None] * b_mat
    bu = jnp.einsum('bsgi,gpi->bsgp', uf.astype(jnp.complex64), b_bar)
    a = jnp.broadcast_to(lam_bar, bu.shape)
    _, states = lax.associative_scan(_linear_combine, (a, bu), axis=1)
    c_mat = lax.complex(c_re.astype(f32), c_im.astype(f32))
    y = jnp.einsum('bsgp,gip->bsgi', states, c_mat).real
    y = y + d_skip.astype(f32).reshape(S5_GROUPS, S5_GROUP) * uf
    y = jax.nn.gelu(y.reshape(bsz, s, MIX))
    return (y * jax.nn.sigmoid(y @ w_glu.astype(f32) + b_glu.astype(f32))).astype(u.dtype)


def causal_conv(x, w, b):
    c = x.shape[-1]
    y = lax.conv_general_dilated(x, w[:, None, :].astype(x.dtype), window_strides=(1,),
                                 padding=[(CONV_W - 1, 0)],
                                 dimension_numbers=('NWC', 'WIO', 'NWC'),
                                 feature_group_count=c)
    return y + b.astype(x.dtype)


def mlstm_chunkwise(q, k, v, ig, fg):
    bsz, h, s, d = q.shape
    L = ML_CHUNK
    nc = s // L
    q = q.reshape(bsz, h, nc, L, d)
    k = k.reshape(bsz, h, nc, L, d)
    v = v.reshape(bsz, h, nc, L, d)
    ii = ig.reshape(bsz, h, nc, L)
    bcum = jnp.cumsum(jax.nn.log_sigmoid(fg).reshape(bsz, h, nc, L), axis=-1)
    g = bcum[..., -1]
    a = g[..., None] - bcum + ii

    def step(carry, xs):
        c_st, n_st, m_st = carry
        kc, vc, ac, gc = xs
        m_new = jnp.maximum(gc + m_st, jnp.max(ac, axis=-1))
        w = jnp.exp(ac - m_new[..., None])
        decay = jnp.exp(gc + m_st - m_new)
        kw = kc * w[..., None]
        c_new = decay[..., None, None] * c_st + jnp.einsum('bhld,bhle->bhde', kw, vc)
        n_new = decay[..., None] * n_st + jnp.sum(kw, axis=2)
        return (c_new, n_new, m_new), (c_st, n_st, m_st)

    init = (jnp.zeros((bsz, h, d, d), jnp.float32), jnp.zeros((bsz, h, d), jnp.float32),
            jnp.zeros((bsz, h), jnp.float32))
    xs = (jnp.moveaxis(k, 2, 0), jnp.moveaxis(v, 2, 0), jnp.moveaxis(a, 2, 0), jnp.moveaxis(g, 2, 0))
    _, (cs, ns, ms) = lax.scan(step, init, xs)
    cs = jnp.moveaxis(cs, 0, 2)
    ns = jnp.moveaxis(ns, 0, 2)
    ms = jnp.moveaxis(ms, 0, 2)

    causal = jnp.tril(jnp.ones((L, L), dtype=bool))
    dlog = jnp.where(causal, bcum[..., :, None] - bcum[..., None, :] + ii[..., None, :], -jnp.inf)
    inter_log = bcum + ms[..., None]
    m_t = jnp.maximum(inter_log, jnp.max(dlog, axis=-1))
    dw = jnp.exp(dlog - m_t[..., None])
    inter_w = jnp.exp(inter_log - m_t)
    sc = jnp.einsum('bhctd,bhcsd->bhcts', q, k) * dw
    num = inter_w[..., None] * jnp.einsum('bhctd,bhcde->bhcte', q, cs) + jnp.einsum('bhcts,bhcse->bhcte', sc, v)
    den = inter_w * jnp.einsum('bhctd,bhcd->bhct', q, ns) + jnp.sum(sc, axis=-1)
    out = num / jnp.maximum(jnp.abs(den), jnp.exp(-m_t))[..., None]
    return out.reshape(bsz, h, s, d)


def mlstm_mixer(c_qk, c_v, c_o, c_if, conv_w, conv_b, hn_g):
    f32 = jnp.float32
    qk = jax.nn.silu(causal_conv(c_qk, conv_w, conv_b))
    q = split_heads(qk[..., :MIX], ML_HEADS).astype(f32)
    k = split_heads(qk[..., MIX:], ML_HEADS).astype(f32) * (HEAD_DIM ** -0.5)
    v = split_heads(c_v, ML_HEADS).astype(f32)
    ig = c_if[..., :ML_HEADS].astype(f32).transpose(0, 2, 1)
    fg = c_if[..., ML_HEADS:].astype(f32).transpose(0, 2, 1)
    hh = mlstm_chunkwise(q, k, v, ig, fg)
    hh = rmsnorm(hh, hn_g.reshape(ML_HEADS, 1, HEAD_DIM))
    return (merge_heads(hh) * jax.nn.sigmoid(c_o.astype(f32))).astype(c_v.dtype)


_gather_blocks = jax.vmap(jax.vmap(lambda blocks, ids: blocks[ids]))


def moba_attention(q, k, v):
    bsz, h, s, d = q.shape
    nb = -(-s // MB_BLOCK)
    pad = nb * MB_BLOCK - s
    kb = jnp.pad(k, ((0, 0), (0, 0), (0, pad), (0, 0))).reshape(bsz, h, nb, MB_BLOCK, d)
    vb = jnp.pad(v, ((0, 0), (0, 0), (0, pad), (0, 0))).reshape(bsz, h, nb, MB_BLOCK, d)
    kmean = jnp.mean(kb.astype(jnp.float32), axis=3)
    n_sel = min(MB_TOPK, nb - 1)
    scale = HEAD_DIM ** -0.5

    def q_block(i):
        start = i * MB_QBLOCK
        qb = lax.dynamic_slice_in_dim(q, start, MB_QBLOCK, axis=2).astype(jnp.float32)
        qpos = start + jnp.arange(MB_QBLOCK)
        own = start // MB_BLOCK
        k_own = lax.dynamic_index_in_dim(kb, own, axis=2, keepdims=False)
        v_own = lax.dynamic_index_in_dim(vb, own, axis=2, keepdims=False)
        kpos = own * MB_BLOCK + jnp.arange(MB_BLOCK)
        s_own = jnp.einsum('bhqd,bhkd->bhqk', qb, k_own) * scale
        s_own = jnp.where(kpos[None, :] <= qpos[:, None], s_own, -jnp.inf)
        if n_sel == 0:
            p = jax.nn.softmax(s_own, axis=-1)
            return jnp.einsum('bhqk,bhkd->bhqd', p, v_own)
        gate = jnp.einsum('bhqd,bhnd->bhqn', qb, kmean)
        gate = jnp.where(jnp.arange(nb) < own, gate, -jnp.inf)
        _, idx = lax.top_k(gate, n_sel)
        valid = idx < own
        k_sel = _gather_blocks(kb, idx)
        v_sel = _gather_blocks(vb, idx)
        s_sel = jnp.einsum('bhqd,bhqnkd->bhqnk', qb, k_sel) * scale
        s_sel = jnp.where(valid[..., None], s_sel, -jnp.inf)
        s_all = jnp.concatenate([s_own, s_sel.reshape(bsz, h, MB_QBLOCK, n_sel * MB_BLOCK)], axis=-1)
        p = jax.nn.softmax(s_all, axis=-1)
        p_own = p[..., :MB_BLOCK]
        p_sel = p[..., MB_BLOCK:].reshape(bsz, h, MB_QBLOCK, n_sel, MB_BLOCK)
        return (jnp.einsum('bhqk,bhkd->bhqd', p_own, v_own)
                + jnp.einsum('bhqnk,bhqnkd->bhqd', p_sel, v_sel))

    outs = lax.map(q_block, jnp.arange(s // MB_QBLOCK))
    return outs.transpose(1, 2, 0, 3, 4).reshape(bsz, h, s, d)


def moba_mixer(d_qkv, qn_g, kn_g):
    q = rope(rmsnorm(split_heads(d_qkv[..., :MIX], MB_HEADS), qn_g))
    k = rope(rmsnorm(split_heads(d_qkv[..., MIX:2 * MIX], MB_HEADS), kn_g))
    v = split_heads(d_qkv[..., 2 * MIX:], MB_HEADS)
    return merge_heads(moba_attention(q, k, v)).astype(d_qkv.dtype)


def even_mixer(xn, w_in, w_out, gm_ws, gm_bs, gm_ln_g, lam_re, lam_im, b_re, b_im, c_re, c_im,
               d_skip, log_step, w_glu, b_glu):
    z = xn @ w_in
    uv = jax.nn.gelu(z[..., :2 * MIX])
    ya = gmlp_mixer(uv[..., :MIX], uv[..., MIX:], gm_ws, gm_bs, gm_ln_g)
    yb = s5_mixer(z[..., 2 * MIX:], lam_re, lam_im, b_re, b_im, c_re, c_im, d_skip, log_step, w_glu, b_glu)
    return (jnp.concatenate([ya, yb], axis=-1) @ w_out).astype(xn.dtype)


def odd_mixer(xn, w_in, w_out, conv_w, conv_b, b_if, hn_g, qn_g, kn_g):
    z = xn @ w_in
    c_qk = z[..., :2 * MIX]
    c_v = z[..., 2 * MIX:3 * MIX]
    c_o = z[..., 3 * MIX:4 * MIX]
    c_if = z[..., 4 * MIX:4 * MIX + 2 * ML_HEADS] + b_if
    d_qkv = z[..., 4 * MIX + 2 * ML_HEADS:]
    yc = mlstm_mixer(c_qk, c_v, c_o, c_if, conv_w, conv_b, hn_g)
    yd = moba_mixer(d_qkv, qn_g, kn_g)
    return (jnp.concatenate([yc, yd], axis=-1) @ w_out).astype(xn.dtype)


def cross_attn(xn, mem_k, mem_v, wq, wo, qn_g, kn_g):
    q = rmsnorm(split_heads(xn @ wq, XA_HEADS), qn_g)
    k = rmsnorm(mem_k, kn_g)
    s = jnp.einsum('bhsd,bhmd->bhsm', q, k).astype(jnp.float32) * (XA_HEAD_DIM ** -0.5)
    p = jax.nn.softmax(s, axis=-1).astype(xn.dtype)
    o = jnp.einsum('bhsm,bhmd->bhsd', p, mem_v)
    return (merge_heads(o) @ wo).astype(xn.dtype)


def hier_moe(xn, w_grp, b_grp, w_exp, b_exp, w1, w3, w2):
    bsz, s, dm = xn.shape
    t = xn.reshape(-1, dm)
    grp_logits = (t @ w_grp + b_grp).astype(jnp.float32)
    grp_p = jax.nn.softmax(grp_logits, axis=-1)
    grp = jnp.argmax(grp_logits, axis=-1)
    exp_logits = (t @ w_exp + b_exp).astype(jnp.float32).reshape(-1, N_GROUPS, EXP_PER_GROUP)
    sel = jnp.take_along_axis(exp_logits, grp[:, None, None], axis=1)[:, 0]
    top_v, top_i = lax.top_k(sel, EXP_TOPK)
    w_tok = jax.nn.softmax(top_v, axis=-1) * jnp.take_along_axis(grp_p, grp[:, None], axis=1)
    eid = grp[:, None] * EXP_PER_GROUP + top_i
    gate = jnp.sum(jax.nn.one_hot(eid, N_EXPERTS, dtype=jnp.float32) * w_tok[..., None], axis=1)
    hid = jax.nn.silu(jnp.einsum('td,edf->tef', t, w1)) * jnp.einsum('td,edf->tef', t, w3)
    hid = hid * gate[..., None].astype(hid.dtype)
    y = hid.reshape(t.shape[0], N_EXPERTS * EXP_FF) @ w2.reshape(N_EXPERTS * EXP_FF, dm)
    return y.reshape(bsz, s, dm).astype(xn.dtype)


def setup_inputs(seed: int = 0) -> dict:
    key = jax.random.key(seed)
    it = iter(jax.random.split(key, 48))
    f32 = jnp.float32

    def nrm(shape, fan_in):
        return jax.random.normal(next(it), shape, f32) * (fan_in ** -0.5)

    def gain(shape):
        return 1.0 + 0.05 * jax.random.normal(next(it), shape, f32)

    def small(shape, sc=0.01):
        return sc * jax.random.normal(next(it), shape, f32)

    L, NE, NO = DEPTH, N_EVEN, N_ODD
    x = jax.random.normal(next(it), (BATCH, SEQ, D_MODEL), f32)
    mem = jax.random.normal(next(it), (BATCH, N_MEM, D_MODEL), f32)
    mem_norm_g = gain((D_MODEL,))
    w_mem_kv = nrm((D_MODEL, 2 * XA_DIM), D_MODEL)
    norm_mix_g = gain((L, D_MODEL))
    norm_xa_g = gain((L, D_MODEL))
    norm_ffn_g = gain((L, D_MODEL))
    xa_wq = nrm((L, D_MODEL, XA_DIM), D_MODEL)
    xa_wo = nrm((L, XA_DIM, D_MODEL), XA_DIM)
    xa_qn_g = gain((L, XA_HEAD_DIM))
    xa_kn_g = gain((L, XA_HEAD_DIM))
    moe_w_grp = nrm((L, D_MODEL, N_GROUPS), D_MODEL)
    moe_b_grp = small((L, N_GROUPS))
    moe_w_exp = nrm((L, D_MODEL, N_EXPERTS), D_MODEL)
    moe_b_exp = small((L, N_EXPERTS))
    moe_w1 = nrm((L, N_EXPERTS, D_MODEL, EXP_FF), D_MODEL)
    moe_w3 = nrm((L, N_EXPERTS, D_MODEL, EXP_FF), D_MODEL)
    moe_w2 = nrm((L, N_EXPERTS, EXP_FF, D_MODEL), EXP_FF)
    ev_w_in = nrm((NE, D_MODEL, EVEN_IN), D_MODEL)
    ev_w_out = nrm((NE, 2 * MIX, D_MODEL), 2 * MIX)
    gm_ws = nrm((NE, GM_HEADS, GM_CHUNK, GM_CHUNK), GM_CHUNK)
    gm_bs = 1.0 + small((NE, GM_HEADS, GM_CHUNK), 0.05)
    gm_ln_g = gain((NE, MIX))
    s5_lam_re = -0.5 + small((NE, S5_GROUPS, S5_STATE))
    s5_lam_im = (jnp.pi * jnp.arange(S5_STATE, dtype=f32))[None, None, :] + small((NE, S5_GROUPS, S5_STATE))
    s5_b_re = nrm((NE, S5_GROUPS, S5_STATE, S5_GROUP), 2 * S5_GROUP)
    s5_b_im = nrm((NE, S5_GROUPS, S5_STATE, S5_GROUP), 2 * S5_GROUP)
    s5_c_re = nrm((NE, S5_GROUPS, S5_GROUP, S5_STATE), 2 * S5_STATE)
    s5_c_im = nrm((NE, S5_GROUPS, S5_GROUP, S5_STATE), 2 * S5_STATE)
    s5_d = jax.random.normal(next(it), (NE, MIX), f32)
    s5_log_step = jax.random.uniform(next(it), (NE, S5_GROUPS), f32,
                                     minval=math.log(S5_DT_MIN), maxval=math.log(S5_DT_MAX))
    s5_w_glu = nrm((NE, MIX, MIX), MIX)
    s5_b_glu = small((NE, MIX))
    od_w_in = nrm((NO, D_MODEL, ODD_IN), D_MODEL)
    od_w_out = nrm((NO, 2 * MIX, D_MODEL), 2 * MIX)
    ml_conv_w = nrm((NO, CONV_W, 2 * MIX), CONV_W)
    ml_conv_b = small((NO, 2 * MIX))
    ml_b_if = jnp.concatenate([small((NO, ML_HEADS), 0.1),
                               jnp.linspace(3.0, 6.0, ML_HEADS, dtype=f32)[None, :] + small((NO, ML_HEADS))], axis=-1)
    ml_hn_g = gain((NO, MIX))
    mb_qn_g = gain((NO, HEAD_DIM))
    mb_kn_g = gain((NO, HEAD_DIM))
    return {'x': x, 'mem': mem, 'mem_norm_g': mem_norm_g, 'w_mem_kv': w_mem_kv,
            'norm_mix_g': norm_mix_g, 'norm_xa_g': norm_xa_g, 'norm_ffn_g': norm_ffn_g,
            'xa_wq': xa_wq, 'xa_wo': xa_wo, 'xa_qn_g': xa_qn_g, 'xa_kn_g': xa_kn_g,
            'moe_w_grp': moe_w_grp, 'moe_b_grp': moe_b_grp, 'moe_w_exp': moe_w_exp, 'moe_b_exp': moe_b_exp,
            'moe_w1': moe_w1, 'moe_w3': moe_w3, 'moe_w2': moe_w2,
            'ev_w_in': ev_w_in, 'ev_w_out': ev_w_out, 'gm_ws': gm_ws, 'gm_bs': gm_bs, 'gm_ln_g': gm_ln_g,
            's5_lam_re': s5_lam_re, 's5_lam_im': s5_lam_im, 's5_b_re': s5_b_re, 's5_b_im': s5_b_im,
            's5_c_re': s5_c_re, 's5_c_im': s5_c_im, 's5_d': s5_d, 's5_log_step': s5_log_step,
            's5_w_glu': s5_w_glu, 's5_b_glu': s5_b_glu,
            'od_w_in': od_w_in, 'od_w_out': od_w_out, 'ml_conv_w': ml_conv_w, 'ml_conv_b': ml_conv_b,
            'ml_b_if': ml_b_if, 'ml_hn_g': ml_hn_g, 'mb_qn_g': mb_qn_g, 'mb_kn_g': mb_kn_g}


def reference(x, mem, mem_norm_g, w_mem_kv, norm_mix_g, norm_xa_g, norm_ffn_g, xa_wq, xa_wo, xa_qn_g,
              xa_kn_g, moe_w_grp, moe_b_grp, moe_w_exp, moe_b_exp, moe_w1, moe_w3, moe_w2, ev_w_in,
              ev_w_out, gm_ws, gm_bs, gm_ln_g, s5_lam_re, s5_lam_im, s5_b_re, s5_b_im, s5_c_re, s5_c_im,
              s5_d, s5_log_step, s5_w_glu, s5_b_glu, od_w_in, od_w_out, ml_conv_w, ml_conv_b, ml_b_if,
              ml_hn_g, mb_qn_g, mb_kn_g):
    mkv = rmsnorm(mem, mem_norm_g) @ w_mem_kv
    mem_k = split_heads(mkv[..., :XA_DIM], XA_HEADS)
    mem_v = split_heads(mkv[..., XA_DIM:], XA_HEADS)
    h = x
    for layer in range(DEPTH):
        j = layer // 2
        xn = rmsnorm(h, norm_mix_g[layer])
        if layer % 2 == 0:
            mix = even_mixer(xn, ev_w_in[j], ev_w_out[j], gm_ws[j], gm_bs[j], gm_ln_g[j],
                             s5_lam_re[j], s5_lam_im[j], s5_b_re[j], s5_b_im[j], s5_c_re[j], s5_c_im[j],
                             s5_d[j], s5_log_step[j], s5_w_glu[j], s5_b_glu[j])
        else:
            mix = odd_mixer(xn, od_w_in[j], od_w_out[j], ml_conv_w[j], ml_conv_b[j], ml_b_if[j],
                            ml_hn_g[j], mb_qn_g[j], mb_kn_g[j])
        h = h + mix
        h = h + cross_attn(rmsnorm(h, norm_xa_g[layer]), mem_k, mem_v, xa_wq[layer], xa_wo[layer],
                           xa_qn_g[layer], xa_kn_g[layer])
        h = h + hier_moe(rmsnorm(h, norm_ffn_g[layer]), moe_w_grp[layer], moe_b_grp[layer],
                         moe_w_exp[layer], moe_b_exp[layer], moe_w1[layer], moe_w3[layer], moe_w2[layer])
    return h
```

```cpp
#include <hip/hip_runtime.h>
#include <cstdio>
#include <cstdint>

#ifndef REP_NORM
#define REP_NORM 1
#endif
#ifndef REP_PRO
#define REP_PRO 1
#endif
#ifndef REP_BAR
#define REP_BAR 1
#endif
#ifndef REP_GIN
#define REP_GIN 1
#endif
#ifndef REP_UP
#define REP_UP 1
#endif
#ifndef REP_ROUTER
#define REP_ROUTER 1
#endif
#ifndef REP_KHAT
#define REP_KHAT 1
#endif
#ifndef REP_RES
#define REP_RES 1
#endif
#ifndef REP_DN
#define REP_DN 1
#endif
#ifndef REP_UPG
#define REP_UPG 1
#endif
#ifndef REP_S5
#define REP_S5 1
#endif
#ifndef REP_GMLP
#define REP_GMLP 1
#endif
#ifndef REP_M1
#define REP_M1 1
#endif
#ifndef REP_M3
#define REP_M3 1
#endif
#ifndef REP_MATTN
#define REP_MATTN 1
#endif
#ifndef REP_XATTN
#define REP_XATTN 1
#endif
#ifndef MK_PER_PHASE
#define MK_PER_PHASE 0
#endif

#define LAS __attribute__((address_space(3)))
typedef unsigned short bf16_t;
typedef short bf16x8 __attribute__((ext_vector_type(8)));
typedef short s16x4 __attribute__((ext_vector_type(4)));
typedef float f32x4 __attribute__((ext_vector_type(4)));
typedef float f32x2 __attribute__((ext_vector_type(2)));
typedef unsigned u32x4 __attribute__((ext_vector_type(4)));
typedef unsigned u32x2 __attribute__((ext_vector_type(2)));
typedef __bf16 bf16x2_t __attribute__((ext_vector_type(2)));

constexpr int D = 1024, BATCH = 8, SEQ = 2048, T = BATCH * SEQ, DEPTH = 4;
constexpr int MIX = 512, NMEM = 256, NTHR = 512;
constexpr int EVEN_IN = 1536, ODD_IN = 3592, ODD_N = 3584, ODD_NP = 3840;
constexpr float EPS = 1e-6f;
constexpr float LOG2E = 1.4426950408889634f;

constexpr size_t al256(size_t x) { return (x + 255) & ~(size_t)255; }
constexpr size_t WS_CTL = 0;
constexpr size_t CTL_BYTES = 16384;
constexpr size_t WS_WMKV = WS_CTL + CTL_BYTES;
constexpr size_t WS_WXQ = WS_WMKV + (size_t)2048 * 1024 * 2;
constexpr size_t WS_WXO = WS_WXQ + (size_t)4 * 1024 * 1024 * 2;
constexpr size_t WS_WUP = WS_WXO + (size_t)4 * 1024 * 1024 * 2;
constexpr size_t WS_WDN = WS_WUP + (size_t)8 * 4096 * 1024 * 2;
constexpr size_t WS_WEVIN = WS_WDN + (size_t)4 * 1024 * 4096 * 2;
constexpr size_t WS_WEVOUT = WS_WEVIN + (size_t)2 * 1536 * 1024 * 2;
constexpr size_t WS_WGLU = WS_WEVOUT + (size_t)2 * 1024 * 1024 * 2;
constexpr size_t WS_WODIN = WS_WGLU + (size_t)2 * 512 * 512 * 2;
constexpr size_t WS_WODOUT = WS_WODIN + (size_t)2 * 3840 * 1024 * 2;
constexpr size_t WS_GMW = WS_WODOUT + (size_t)2 * 1024 * 1024 * 2;
constexpr size_t WS_WRT = WS_GMW + (size_t)2 * 4 * 128 * 128 * 2;
constexpr size_t WS_WIFT = WS_WRT + (size_t)4 * 20 * 1024 * 4;
constexpr size_t WS_LAMB = WS_WIFT + (size_t)2 * 8 * 1024 * 4;
constexpr size_t WS_BBAR = WS_LAMB + (size_t)2 * 32 * 64 * 2 * 4;
constexpr size_t WS_KSUM = WS_BBAR + (size_t)2 * 32 * 64 * 16 * 2 * 4;
constexpr size_t WS_GATES = WS_KSUM + (size_t)8 * 4 * 8 * 128 * 4;
constexpr size_t WS_GATEW = WS_GATES + (size_t)T * 8 * 4;
constexpr size_t WS_MIDX = WS_GATEW + (size_t)T * 16 * 4;
constexpr size_t WS_MCNT = WS_MIDX + (size_t)4 * T * 4;
constexpr size_t WS_WRB = WS_MCNT + 4096;
constexpr size_t WS_MLOC = WS_WRB + (size_t)4 * 2 * 32 * 1024 * 2;
constexpr size_t WS_GSUM = WS_MLOC + 2048;
constexpr size_t WS_MS = WS_GSUM + 2048;
constexpr size_t WS_NLOC = WS_MS + 2048;
constexpr size_t WS_MEMN = WS_NLOC + (size_t)512 * 128 * 4;
constexpr size_t WS_MKV = WS_MEMN + (size_t)2048 * 1024 * 2;
constexpr size_t WS_XN = WS_MKV + (size_t)2048 * 2048 * 2;
constexpr size_t WS_CAT = WS_XN + (size_t)T * 1024 * 2;
constexpr size_t WS_SS = WS_CAT + (size_t)T * 1024 * 2;
constexpr size_t WS_RSTD = WS_SS + (size_t)2 * T * 16 * 4;
constexpr size_t WS_RSL = WS_RSTD + (size_t)T * 4;
constexpr size_t WS_BIG = WS_RSL + (size_t)4 * T * 4;
constexpr size_t WS_KV = WS_BIG + (size_t)T * 3584 * 2;
constexpr size_t WS_END = WS_KV + (size_t)512 * 128 * 128 * 2;

#define otid() ((WV_ << 6) | olane())
__device__ __forceinline__ unsigned pk2(float lo, float hi) { f32x2 v = {lo, hi}; bf16x2_t b = __builtin_convertvector(v, bf16x2_t); return __builtin_bit_cast(unsigned, b); }
__device__ __forceinline__ bf16_t f2bf(float f) { return (bf16_t)(pk2(f, 0.f) & 0xffffu); }
__device__ __forceinline__ float bf2f(unsigned b) { return __uint_as_float(b << 16); }
__device__ __forceinline__ float bflo(unsigned w) { return __uint_as_float(w << 16); }
__device__ __forceinline__ float bfhi(unsigned w) { return __uint_as_float(w & 0xffff0000u); }
__device__ __forceinline__ float fexp2(float x) { return __builtin_amdgcn_exp2f(x); }
__device__ __forceinline__ float fexp(float x) { return __builtin_amdgcn_exp2f(x * LOG2E); }
__device__ __forceinline__ float frcp(float x) { return __builtin_amdgcn_rcpf(x); }
__device__ __forceinline__ float sigmoidf_(float x) { return frcp(1.f + fexp(-x)); }
__device__ __forceinline__ float siluf_(float x) { return x * sigmoidf_(x); }
__device__ __forceinline__ float gelu_tanh(float x) { const float y = 1.5957691216057308f * (x + 0.044715f * x * x * x); return x * sigmoidf_(y); }
__device__ __forceinline__ float logsigmoidf_(float x) { return fminf(x, 0.f) - __logf(1.f + fexp(-fabsf(x))); }
template <class P> __device__ __forceinline__ P* opq(P* p) { int z_ = 0; asm volatile("" : "+s"(z_)); return p + z_; }
__device__ __forceinline__ int olane() { unsigned z_ = 0u; asm volatile("" : "+v"(z_)); return (int)__builtin_amdgcn_mbcnt_hi(~0u, __builtin_amdgcn_mbcnt_lo(~0u, z_)); }
__device__ __forceinline__ float shx(float v, int o) { return __builtin_bit_cast(float, __builtin_amdgcn_ds_bpermute((olane() ^ o) << 2, __builtin_bit_cast(int, v))); }
__device__ __forceinline__ float shf(float v, int src) { return __builtin_bit_cast(float, __builtin_amdgcn_ds_bpermute(src << 2, __builtin_bit_cast(int, v))); }
template <int CTRL> __device__ __forceinline__ float dppf(float v) { return __builtin_bit_cast(float, __builtin_amdgcn_update_dpp(0, __builtin_bit_cast(int, v), CTRL, 0xf, 0xf, false)); }
__device__ __forceinline__ float xor1f(float v) { return dppf<0xB1>(v); }
__device__ __forceinline__ float xor2f(float v) { return dppf<0x4E>(v); }
__device__ __forceinline__ float xor16f(float v) { return __builtin_bit_cast(float, __builtin_amdgcn_ds_swizzle(__builtin_bit_cast(int, v), 0x401F)); }
__device__ __forceinline__ float sum_x32(float v) { const int iv = __builtin_bit_cast(int, v); auto r = __builtin_amdgcn_permlane32_swap(iv, iv, false, false); return __builtin_bit_cast(float, (int)r[0]) + __builtin_bit_cast(float, (int)r[1]); }
__device__ __forceinline__ float max_x32(float v) { const int iv = __builtin_bit_cast(int, v); auto r = __builtin_amdgcn_permlane32_swap(iv, iv, false, false); return fmaxf(__builtin_bit_cast(float, (int)r[0]), __builtin_bit_cast(float, (int)r[1])); }
__device__ __forceinline__ float sum4(float v) { v += xor1f(v); v += xor2f(v); return v; }
__device__ __forceinline__ float sum8(float v) { v = sum4(v); v += dppf<0x141>(v); return v; }
__device__ __forceinline__ float sum16(float v) { v = sum8(v); v += dppf<0x140>(v); return v; }
template <int CTRL, int RM, int BM> __device__ __forceinline__ float dppm(float old, float v) { return __builtin_bit_cast(float, __builtin_amdgcn_update_dpp(__builtin_bit_cast(int, old), __builtin_bit_cast(int, v), CTRL, RM, BM, false)); }
__device__ __forceinline__ float wave_scan_add(float v) {
    float s = v + dppm<0x111, 0xf, 0xf>(0.f, v);
    s += dppm<0x112, 0xf, 0xf>(0.f, v);
    s += dppm<0x113, 0xf, 0xf>(0.f, v);
    s += dppm<0x114, 0xf, 0xe>(0.f, s);
    s += dppm<0x118, 0xf, 0xc>(0.f, s);
    s += dppm<0x142, 0xa, 0xf>(0.f, s);
    s += dppm<0x143, 0xc, 0xf>(0.f, s);
    return s;
}
__device__ __forceinline__ float wave_scan_max(float v) {
    constexpr float NI = -3.0e38f;
    float s = fmaxf(v, dppm<0x111, 0xf, 0xf>(NI, v));
    s = fmaxf(s, dppm<0x112, 0xf, 0xf>(NI, v));
    s = fmaxf(s, dppm<0x113, 0xf, 0xf>(NI, v));
    s = fmaxf(s, dppm<0x114, 0xf, 0xe>(NI, s));
    s = fmaxf(s, dppm<0x118, 0xf, 0xc>(NI, s));
    s = fmaxf(s, dppm<0x142, 0xa, 0xf>(NI, s));
    s = fmaxf(s, dppm<0x143, 0xc, 0xf>(NI, s));
    return s;
}
__device__ __forceinline__ float wave_shr1(float old, float v) { return dppm<0x138, 0xf, 0xf>(old, v); }
__device__ __forceinline__ float max16(float v) { v = fmaxf(v, xor1f(v)); v = fmaxf(v, xor2f(v)); v = fmaxf(v, dppf<0x141>(v)); v = fmaxf(v, dppf<0x140>(v)); return v; }
__device__ __forceinline__ float sum_rows(float v) { v += xor16f(v); return sum_x32(v); }
__device__ __forceinline__ float wave_sum(float v) { return sum_rows(sum16(v)); }
__device__ __forceinline__ void unpack8(const u32x4 v, float (&f)[8]) { f[0] = bflo(v.x); f[1] = bfhi(v.x); f[2] = bflo(v.y); f[3] = bfhi(v.y); f[4] = bflo(v.z); f[5] = bfhi(v.z); f[6] = bflo(v.w); f[7] = bfhi(v.w); }
__device__ __forceinline__ u32x4 zero4() { unsigned z; asm volatile("v_mov_b32 %0, 0" : "=v"(z)); return (u32x4){z, z, z, z}; }
__device__ __forceinline__ u32x4 pack8(const float (&f)[8]) { u32x4 v; v.x = pk2(f[0], f[1]); v.y = pk2(f[2], f[3]); v.z = pk2(f[4], f[5]); v.w = pk2(f[6], f[7]); return v; }

__device__ __forceinline__ bf16x8 frag_row(const LAS unsigned char* base, int ld, int row0, int k0, int lane) {
    return *(const LAS bf16x8*)(base + (row0 + (lane & 15)) * ld + (k0 + 8 * (lane >> 4)) * 2);
}
__device__ __forceinline__ bf16x8 frag_tr(const LAS unsigned char* base, int ld, int k0, int col0, int lane) {
    const int g = lane >> 4, q = (lane & 15) >> 2, p = lane & 3;
    const LAS unsigned char* a = base + (k0 + 8 * g + q) * ld + (col0 + 4 * p) * 2;
    const s16x4 v0 = __builtin_amdgcn_ds_read_tr16_b64_v4i16((LAS s16x4*)a);
    const s16x4 v1 = __builtin_amdgcn_ds_read_tr16_b64_v4i16((LAS s16x4*)(a + 4 * ld));
    return (bf16x8){v0[0], v0[1], v0[2], v0[3], v1[0], v1[1], v1[2], v1[3]};
}
#define MFMA16(a, b, c) __builtin_amdgcn_mfma_f32_16x16x32_bf16((a), (b), (c), 0, 0, 0)

__device__ __forceinline__ void stage_tile(unsigned char* dst, int dld, const bf16_t* src, size_t sld, int rows, int cols, int tid) {
    const int cpr = cols >> 3, n = rows * cpr;
    for (int i = tid; i < n; i += NTHR) { const int r = i / cpr, c = i - r * cpr;
        *(u32x4*)(dst + r * dld + c * 16) = *(const u32x4*)(src + (size_t)r * sld + c * 8); }
}

#define XB_TMO      128
#define XB_XCNT(j)  (256  + 64 * (j))
#define XB_XSUB(j)  (1280 + 64 * (j))
#define XB_XGEN(j)  (2304 + 64 * (j))
#define XB_TOP      3328
#define XB_TOPGEN   3392
#define XCD_BAR_WORDS 3456
#define XB_SPIN_CAP (1u << 21)
__device__ __forceinline__ unsigned xb_ld(unsigned* p)              { return __hip_atomic_load(p, __ATOMIC_RELAXED, __HIP_MEMORY_SCOPE_AGENT); }
__device__ __forceinline__ unsigned xb_add(unsigned* p, unsigned v) { return __hip_atomic_fetch_add(p, v, __ATOMIC_RELAXED, __HIP_MEMORY_SCOPE_AGENT); }
__device__ __forceinline__ unsigned xb_xcc_id() { return (unsigned)__builtin_amdgcn_s_getreg((3 << 11) | 20) & 0xFu; }
#define XB_SPIN(cond, bar) do { unsigned _sp = 0; while (cond) { __builtin_amdgcn_s_sleep(1); \
    if ((++_sp & 255u) == 0u) { if (xb_ld(&(bar)[XB_TMO])) break; if (_sp > XB_SPIN_CAP) { atomicAdd(&(bar)[XB_TMO], 1u); break; } } } } while (0)
struct XcdBarrier { unsigned* bar; unsigned x; volatile LAS unsigned* st; };
__device__ __forceinline__ XcdBarrier xcd_barrier_post(unsigned* bar, volatile LAS unsigned* st) {
    XcdBarrier b; b.bar = bar; b.x = xb_xcc_id(); b.st = st;
    if (threadIdx.x == 0) (void)xb_add(&bar[XB_XCNT(b.x)], 1u);
    return b;
}
__device__ __forceinline__ void xcd_barrier_complete(unsigned* bar, unsigned x, unsigned& nloc, unsigned& nx) {
    const unsigned G = gridDim.x * gridDim.y * gridDim.z;
    unsigned sum, cnt, mine, sp = 0u;
    for (;;) {
        sum = 0u; cnt = 0u; mine = 0u;
#pragma unroll
        for (unsigned j = 0; j < 16; ++j) { const unsigned c = xb_ld(&bar[XB_XCNT(j)]); sum += c; cnt += (c > 0u) ? 1u : 0u; mine = (j == x) ? c : mine; }
        if (sum == G) break;
        __builtin_amdgcn_s_sleep(1);
        if ((++sp & 255u) == 0u) { if (xb_ld(&bar[XB_TMO])) break; if (sp > XB_SPIN_CAP) { atomicAdd(&bar[XB_TMO], 1u); break; } }
    }
    nloc = mine > 0u ? mine : 1u; nx = cnt > 0u ? cnt : 1u;
}
__device__ __forceinline__ void xcd_barrier(const XcdBarrier& b) {
    asm volatile("s_waitcnt vmcnt(0)" ::: "memory");
    __syncthreads();
    if (threadIdx.x == 0) {
        unsigned* bar = opq(b.bar);
        __builtin_amdgcn_s_waitcnt(0);
        unsigned nloc = b.st[0], nx = b.st[1];
        unsigned bx_ = __builtin_amdgcn_readfirstlane(b.x); asm volatile("" : "+s"(bx_));
        if (nloc == 0u) { xcd_barrier_complete(bar, bx_, nloc, nx); b.st[0] = nloc; b.st[1] = nx; }
        const unsigned old = xb_add(&bar[XB_XSUB(bx_)], 1u);
        const unsigned gen = old / nloc;
        if (old + 1u == (gen + 1u) * nloc) {
            __builtin_amdgcn_fence(__ATOMIC_RELEASE, "agent");
            asm volatile("s_waitcnt vmcnt(0)" ::: "memory");
            const unsigned og = xb_add(&bar[XB_TOP], 1u);
            const unsigned tg = og / nx;
            if (og + 1u != (tg + 1u) * nx) XB_SPIN(xb_ld(&bar[XB_TOP]) < (tg + 1u) * nx, bar);
            __builtin_amdgcn_fence(__ATOMIC_ACQUIRE, "agent");
            xb_add(&bar[XB_XGEN(bx_)], 1u);
            asm volatile("s_waitcnt vmcnt(0)" ::: "memory");
        } else {
            XB_SPIN(xb_ld(&bar[XB_XGEN(bx_)]) == gen, bar);
            __builtin_amdgcn_fence(__ATOMIC_ACQUIRE, "agent");
            asm volatile("s_waitcnt vmcnt(0)" ::: "memory");
        }
    }
    __syncthreads();
}

#define GB_XCC(c) (3520 + (c))
#define GB_CNT(g) (3776 + (g))
__device__ __forceinline__ void group_sync(unsigned* ctl, int gid, unsigned k, unsigned same) {
    asm volatile("s_waitcnt vmcnt(0)" ::: "memory");
    __syncthreads();
    if (threadIdx.x == 0) {
        unsigned* c = opq(ctl) + GB_CNT(gid);
        __builtin_amdgcn_s_waitcnt(0);
        if (!same) __builtin_amdgcn_fence(__ATOMIC_RELEASE, "agent");
        asm volatile("s_waitcnt vmcnt(0)" ::: "memory");
        (void)xb_add(c, 1u);
        XB_SPIN(xb_ld(c) < 4u * (k + 1u), opq(ctl));
        __builtin_amdgcn_fence(__ATOMIC_ACQUIRE, "agent");
        asm volatile("s_waitcnt vmcnt(0)" ::: "memory");
    }
    __syncthreads();
}

namespace pg8 {
constexpr int BM = 256, BK = 64, HALF = 128, HTB = HALF * BK * 2, STAGE_BYTES = 8 * HTB, NXCD = 8, WGM = 8;
__device__ __forceinline__ int lds_byte(int r, int c) { const int st = (r >> 4) * 2 + (c >> 5), rr = r & 15, cc = c & 31, ob = rr * 64 + cc * 2; return st * 1024 + (ob ^ (((ob >> 9) & 1) << 5)); }
__device__ __forceinline__ void stage_rc(int b, int& R, int& C) { const int st = b / 1024, sb = b % 1024, swz = sb ^ (((sb >> 9) & 1) << 5); R = (st >> 1) * 16 + swz / 64; C = (st & 1) * 32 + (swz % 64) / 2; }
__device__ __forceinline__ int perm32(int rho) { const int n = rho >> 4, i = rho & 15; return 8 * (i >> 2) + 4 * n + (i & 3); }
struct Unit { int pm, pn; };
struct Gemm { const bf16_t* A; const bf16_t* Bt; };
template <int M, int N> struct StaticOrder {
    static constexpr int nM = M / BM, nN = N / BM, nwg = nM * nN;
    int G, c;
    __device__ void init(int G_, int c_) { G = G_; c = c_; }
    __device__ bool next(int i, Unit& u) const {
        const int L = i * G + c; if (L >= nwg) return false;
        int wgid = L; { constexpr int q = nwg / NXCD, r = nwg % NXCD; const int xcd = wgid % NXCD, off = wgid / NXCD; wgid = (xcd < r ? xcd * (q + 1) : r * (q + 1) + (xcd - r) * q) + off; }
        constexpr int nig = WGM * nN; const int gid = wgid / nig, fm = gid * WGM, gsz = (nM - fm) < WGM ? (nM - fm) : WGM;
        u.pm = fm + ((wgid % nig) % gsz); u.pn = (wgid % nig) / gsz; return true;
    }
};

struct OneUnit { int pm, pn; bool valid; __device__ __forceinline__ bool next(int i, Unit& u) const { if (i != 0 || !valid) return false; u.pm = pm; u.pn = pn; return true; } };
template <class Epi, int M, int N, int K, int LDA, int LDB, class Order>
__device__ __forceinline__ void gemm_phase(int WV_, LAS unsigned char* lds, const Gemm g, const Order& S, const Epi& E) {
    const int tid = otid(), wid = __builtin_amdgcn_readfirstlane(tid >> 6), lane = tid & 63, wr = wid >> 2, wc = wid & 3, fr = lane & 15, fq = lane >> 4;
    constexpr int nt = K / BK;
    unsigned voffA[2], voffB[2];
#pragma unroll
    for (int i = 0; i < 2; ++i) { int R, C; stage_rc(tid * 16 + i * 8192, R, C); const int Rb = Epi::PERM ? ((R & ~31) + perm32(R & 31)) : R;
        voffA[i] = (unsigned)(R * LDA + C) * 2u; voffB[i] = (unsigned)(Rb * LDB + C) * 2u; }
    constexpr size_t kstep = (size_t)(BK * 2);
    constexpr size_t hstepA = (size_t)HALF * LDA * 2, hstepB = (size_t)HALF * LDB * 2;
    constexpr size_t tstepA = 2 * hstepA, tstepB = 2 * hstepB;
    const unsigned ldsw = (unsigned)wid * 1024u;
    const int aoff = lds_byte(wr * 64 + fr, fq * 8), boff = lds_byte(wc * 32 + fr, fq * 8);
#define PG8_SA(b, h) (((b) * 2 + (h)) * HTB)
#define PG8_SB(b, h) ((4 + (b) * 2 + (h)) * HTB)
#define PG8_STAGE(bufoff, gbase, voff) do { _Pragma("unroll") for (int _i = 0; _i < 2; ++_i) \
        __builtin_amdgcn_global_load_lds((const unsigned*)((const char*)(gbase) + (voff)[_i]), (LAS unsigned*)(lds + (bufoff) + ldsw + _i * 8192), 16, 0, 0); } while (0)
#define PG8_LDA(dst, b, h) do { _Pragma("unroll") for (int m = 0; m < 4; ++m) _Pragma("unroll") for (int k = 0; k < 2; ++k) dst[m][k] = *(const LAS bf16x8*)(lds + PG8_SA(b, h) + aoff + m * 2048 + k * 1024); } while (0)
#define PG8_LDB(dst, b, h) do { _Pragma("unroll") for (int n = 0; n < 2; ++n) _Pragma("unroll") for (int k = 0; k < 2; ++k) dst[n][k] = *(const LAS bf16x8*)(lds + PG8_SB(b, h) + boff + n * 2048 + k * 1024); } while (0)
#define PG8_MMA(ai, bj, At, Bt) do { __builtin_amdgcn_s_setprio(1); _Pragma("unroll") for (int m = 0; m < 4; ++m) _Pragma("unroll") for (int n = 0; n < 2; ++n) _Pragma("unroll") for (int k = 0; k < 2; ++k) \
        acc[ai][bj][m][n] = __builtin_amdgcn_mfma_f32_16x16x32_bf16(Bt[n][k], At[m][k], acc[ai][bj][m][n], 0, 0, 0); __builtin_amdgcn_s_setprio(0); } while (0)
#define PG8_WAIT_V(n) asm volatile("s_waitcnt vmcnt(" #n ")" ::: "memory")
#define PG8_WAIT_L(n) asm volatile("s_waitcnt lgkmcnt(" #n ")" ::: "memory")
#define PG8_BAR __builtin_amdgcn_s_barrier()
#define PG8_SCHED __builtin_amdgcn_sched_barrier(0)
    Unit cur, nxt; int ui = 0;
    if (!S.next(0, cur)) return;
    f32x4 acc[2][2][4][2];
#pragma unroll
    for (int a = 0; a < 2; ++a)
#pragma unroll
        for (int b = 0; b < 2; ++b)
#pragma unroll
            for (int m = 0; m < 4; ++m)
#pragma unroll
                for (int n = 0; n < 2; ++n) acc[a][b][m][n] = (f32x4){0.f, 0.f, 0.f, 0.f};
    bf16x8 At[4][2], B0[2][2], B1[2][2];
    const char* cA = (const char*)g.A + (size_t)cur.pm * tstepA; const char* cB = (const char*)g.Bt + (size_t)cur.pn * tstepB;
    PG8_STAGE(PG8_SB(0, 0), cB, voffB); PG8_STAGE(PG8_SA(0, 0), cA, voffA); PG8_STAGE(PG8_SB(0, 1), cB + hstepB, voffB); PG8_STAGE(PG8_SA(0, 1), cA + hstepA, voffA);
    if (wr == 1) PG8_BAR;
    PG8_WAIT_V(4); PG8_BAR;
    PG8_STAGE(PG8_SB(1, 0), cB + kstep, voffB); PG8_STAGE(PG8_SA(1, 0), cA + kstep, voffA); PG8_STAGE(PG8_SB(1, 1), cB + hstepB + kstep, voffB);
    PG8_WAIT_V(6); PG8_BAR;
    for (;;) {
        const bool has_next = S.next(ui + 1, nxt);
        const char* nA = has_next ? (const char*)g.A + (size_t)nxt.pm * tstepA : cA; const char* nB = has_next ? (const char*)g.Bt + (size_t)nxt.pn * tstepB : cB;
        for (int t = 0; t < nt; t += 2) {
            const bool last = (t == nt - 2);
            const char* a1 = cA + (size_t)(t + 1) * kstep;
            const char* a2 = last ? nA : cA + (size_t)(t + 2) * kstep; const char* b2 = last ? nB : cB + (size_t)(t + 2) * kstep;
            const char* a3 = a2 + kstep; const char* b3 = b2 + kstep;
            PG8_LDB(B0, 0, 0); PG8_SCHED; PG8_LDA(At, 0, 0); PG8_STAGE(PG8_SA(1, 1), a1 + hstepA, voffA);
            PG8_WAIT_L(8); PG8_BAR; PG8_WAIT_L(0); PG8_MMA(0, 0, At, B0); PG8_BAR; PG8_SCHED;
            PG8_LDB(B1, 0, 1); PG8_STAGE(PG8_SB(0, 0), b2, voffB);
            PG8_BAR; PG8_WAIT_L(0); PG8_MMA(0, 1, At, B1); PG8_BAR;
            PG8_LDA(At, 0, 1); PG8_STAGE(PG8_SA(0, 0), a2, voffA);
            PG8_BAR; PG8_WAIT_L(0); PG8_MMA(1, 0, At, B0); PG8_BAR; PG8_SCHED;
            PG8_STAGE(PG8_SB(0, 1), b2 + hstepB, voffB);
            PG8_WAIT_V(6); PG8_BAR; PG8_MMA(1, 1, At, B1); PG8_BAR;
            PG8_LDB(B0, 1, 0); PG8_SCHED; PG8_LDA(At, 1, 0); PG8_STAGE(PG8_SA(0, 1), a2 + hstepA, voffA);
            PG8_WAIT_L(8); PG8_BAR; PG8_WAIT_L(0); PG8_MMA(0, 0, At, B0); PG8_BAR; PG8_SCHED;
            PG8_LDB(B1, 1, 1); PG8_STAGE(PG8_SB(1, 0), b3, voffB);
            PG8_BAR; PG8_WAIT_L(0); PG8_MMA(0, 1, At, B1); PG8_BAR;
            PG8_LDA(At, 1, 1); PG8_STAGE(PG8_SA(1, 0), a3, voffA);
            PG8_BAR; PG8_WAIT_L(0); PG8_MMA(1, 0, At, B0); PG8_BAR; PG8_SCHED;
            PG8_STAGE(PG8_SB(1, 1), b3 + hstepB, voffB);
            PG8_WAIT_V(6); PG8_BAR; PG8_MMA(1, 1, At, B1); PG8_BAR;
        }
        E(acc, cur, wr, wc, fr, fq);
        if (!has_next) break;
#pragma unroll
        for (int a = 0; a < 2; ++a)
#pragma unroll
            for (int b = 0; b < 2; ++b)
#pragma unroll
                for (int m = 0; m < 4; ++m)
#pragma unroll
                    for (int n = 0; n < 2; ++n) acc[a][b][m][n] = (f32x4){0.f, 0.f, 0.f, 0.f};
        cur = nxt; cA = nA; cB = nB; ++ui;
    }
    PG8_WAIT_V(0);
    if (wr == 0) PG8_BAR;
    PG8_BAR;
#undef PG8_SA
#undef PG8_SB
#undef PG8_STAGE
#undef PG8_LDA
#undef PG8_LDB
#undef PG8_MMA
#undef PG8_WAIT_V
#undef PG8_WAIT_L
#undef PG8_BAR
#undef PG8_SCHED
}

struct EpiResAddN {
    static constexpr bool PERM = true;
    const float* X; bf16_t* HB; float* ss; float scl;
    __device__ __forceinline__ void operator()(const f32x4 (&acc)[2][2][4][2], const Unit& u, int wr, int wc, int fr, int fq) const {
        const int row0 = u.pm * BM + wr * 64 + fr, col0 = u.pn * BM + wc * 32 + 8 * fq;
        if (X) {
#pragma unroll
            for (int ai = 0; ai < 2; ++ai)
#pragma unroll
                for (int m = 0; m < 4; ++m) { const int row = row0 + ai * HALF + m * 16; float sq = 0.f;
#pragma unroll
                    for (int bj = 0; bj < 2; ++bj) { bf16_t* ph = HB + (size_t)row * D + col0 + bj * HALF; float o[8];
                        const float* pi = X + (size_t)row * D + col0 + bj * HALF; const f32x4 a0 = *(const f32x4*)pi, a1 = *(const f32x4*)(pi + 4);
                        o[0] = a0[0]; o[1] = a0[1]; o[2] = a0[2]; o[3] = a0[3]; o[4] = a1[0]; o[5] = a1[1]; o[6] = a1[2]; o[7] = a1[3];
#pragma unroll
                        for (int j = 0; j < 4; ++j) { o[j] += acc[ai][bj][m][0][j] * scl; o[4 + j] += acc[ai][bj][m][1][j] * scl; }
#pragma unroll
                        for (int j = 0; j < 8; ++j) sq += o[j] * o[j];
                        *(u32x4*)ph = pack8(o); }
                    sq = sum_rows(sq);
                    if (fq == 0 && ss) ss[(size_t)row * 16 + u.pn * 4 + wc] = sq; }
        } else {
#pragma unroll
            for (int ai = 0; ai < 2; ++ai) {
                u32x4 old[4][2];
#pragma unroll
                for (int m = 0; m < 4; ++m)
#pragma unroll
                    for (int bj = 0; bj < 2; ++bj) old[m][bj] = *(const u32x4*)(HB + (size_t)(row0 + ai * HALF + m * 16) * D + col0 + bj * HALF);
                __builtin_amdgcn_sched_barrier(0);
#pragma unroll
                for (int m = 0; m < 4; ++m) { const int row = row0 + ai * HALF + m * 16; float sq = 0.f;
#pragma unroll
                    for (int bj = 0; bj < 2; ++bj) { float o[8]; unpack8(old[m][bj], o);
#pragma unroll
                        for (int j = 0; j < 4; ++j) { o[j] += acc[ai][bj][m][0][j] * scl; o[4 + j] += acc[ai][bj][m][1][j] * scl; }
#pragma unroll
                        for (int j = 0; j < 8; ++j) sq += o[j] * o[j];
                        *(u32x4*)(HB + (size_t)row * D + col0 + bj * HALF) = pack8(o); }
                    sq = sum_rows(sq);
                    if (fq == 0 && ss) ss[(size_t)row * 16 + u.pn * 4 + wc] = sq; }
                __builtin_amdgcn_sched_barrier(0);
            }
        }
    }
};
template <int ACT> struct EpiBf16 {
    static constexpr bool PERM = true;
    bf16_t* O1; int ld1; int nsplit; bf16_t* O2; int ld2; const float* ss; int ngate; float* G;
    __device__ __forceinline__ void operator()(const f32x4 (&acc)[2][2][4][2], const Unit& u, int wr, int wc, int fr, int fq) const {
        const int row0 = u.pm * BM + wr * 64 + fr;
        const bool first = u.pn < nsplit;
        bf16_t* base = first ? O1 : O2; const int ld = first ? ld1 : ld2;
        const int col0 = (first ? u.pn : u.pn - nsplit) * BM + wc * 32 + 8 * fq;
        float rsv[2][4];
        if (ss) { f32x4 pp[2][4];
#pragma unroll
            for (int ai = 0; ai < 2; ++ai)
#pragma unroll
                for (int m = 0; m < 4; ++m) pp[ai][m] = *(const f32x4*)(ss + (size_t)(row0 + ai * HALF + m * 16) * 16 + 4 * fq);
            __builtin_amdgcn_sched_barrier(0);
#pragma unroll
            for (int ai = 0; ai < 2; ++ai)
#pragma unroll
                for (int m = 0; m < 4; ++m) { const float tot = sum_rows((pp[ai][m][0] + pp[ai][m][1]) + (pp[ai][m][2] + pp[ai][m][3])); rsv[ai][m] = 1.f / sqrtf(tot * (1.f / 1024.f) + EPS); }
        } else {
#pragma unroll
            for (int ai = 0; ai < 2; ++ai)
#pragma unroll
                for (int m = 0; m < 4; ++m) rsv[ai][m] = 1.f; }
#pragma unroll
        for (int ai = 0; ai < 2; ++ai)
#pragma unroll
            for (int m = 0; m < 4; ++m) { const int row = row0 + ai * HALF + m * 16;
                const float rs = rsv[ai][m];
                if (u.pn == ngate) { if (wc == 0 && fq == 0) { *(f32x4*)(G + (size_t)row * 8) = acc[ai][0][m][0] * rs; *(f32x4*)(G + (size_t)row * 8 + 4) = acc[ai][0][m][1] * rs; } }
                else { bf16_t* rowp = base + (size_t)row * ld + col0;
#pragma unroll
                for (int bj = 0; bj < 2; ++bj) { f32x4 v0 = acc[ai][bj][m][0] * rs, v1 = acc[ai][bj][m][1] * rs;
                    if (ACT == 1 && first) {
#pragma unroll
                        for (int j = 0; j < 4; ++j) { v0[j] = gelu_tanh(v0[j]); v1[j] = gelu_tanh(v1[j]); } }
                    u32x4 w; w.x = pk2(v0[0], v0[1]); w.y = pk2(v0[2], v0[3]); w.z = pk2(v1[0], v1[1]); w.w = pk2(v1[2], v1[3]);
                    *(u32x4*)(rowp + bj * HALF) = w; } } }
    }
};
struct EpiGlu {
    static constexpr bool PERM = true;
    const bf16_t* Y; int ldy; const float* bias; bf16_t* O; int ldo; int ocol0;
    __device__ __forceinline__ void operator()(const f32x4 (&acc)[2][2][4][2], const Unit& u, int wr, int wc, int fr, int fq) const {
        const int row0 = u.pm * BM + wr * 64 + fr, col0 = u.pn * BM + wc * 32 + 8 * fq;
        f32x4 bb[2][2];
#pragma unroll
        for (int bj = 0; bj < 2; ++bj) { bb[bj][0] = *(const f32x4*)(bias + col0 + bj * HALF); bb[bj][1] = *(const f32x4*)(bias + col0 + bj * HALF + 4); }
#pragma unroll
        for (int ai = 0; ai < 2; ++ai) {
            u32x4 yv[4][2];
#pragma unroll
            for (int m = 0; m < 4; ++m)
#pragma unroll
                for (int bj = 0; bj < 2; ++bj) yv[m][bj] = *(const u32x4*)(Y + (size_t)(row0 + ai * HALF + m * 16) * ldy + col0 + bj * HALF);
            __builtin_amdgcn_sched_barrier(0);
#pragma unroll
            for (int m = 0; m < 4; ++m) { const int row = row0 + ai * HALF + m * 16;
#pragma unroll
                for (int bj = 0; bj < 2; ++bj) { const int c = col0 + bj * HALF;
                    float y[8]; unpack8(yv[m][bj], y);
                    const f32x4 v0 = acc[ai][bj][m][0] + bb[bj][0], v1 = acc[ai][bj][m][1] + bb[bj][1];
                    float o[8];
#pragma unroll
                    for (int j = 0; j < 4; ++j) { o[j] = y[j] * sigmoidf_(v0[j]); o[4 + j] = y[4 + j] * sigmoidf_(v1[j]); }
                    *(u32x4*)(O + (size_t)row * ldo + ocol0 + c) = pack8(o); } }
            __builtin_amdgcn_sched_barrier(0);
        }
    }
};
struct EpiMoeUp {
    static constexpr bool PERM = true;
    bf16_t* H; int ldh; const float* gatew; int ehalf;
    __device__ __forceinline__ void operator()(const f32x4 (&acc)[2][2][4][2], const Unit& u, int wr, int wc, int fr, int fq) const {
        const int row0 = u.pm * BM + wr * 64 + fr, col0 = u.pn * HALF + wc * 32 + 8 * fq, e = ehalf * 8 + (u.pn >> 1);
#pragma unroll
        for (int ai = 0; ai < 2; ++ai)
#pragma unroll
            for (int m = 0; m < 4; ++m) { const int row = row0 + ai * HALF + m * 16;
                const float gw = gatew[(size_t)row * 16 + e];
                float o[8];
#pragma unroll
                for (int n = 0; n < 2; ++n)
#pragma unroll
                    for (int j = 0; j < 4; ++j) o[4 * n + j] = siluf_(acc[ai][0][m][n][j]) * acc[ai][1][m][n][j] * gw;
                *(u32x4*)(H + (size_t)row * ldh + col0) = pack8(o); }
    }
};

struct GUnit { int pn, g, rt, row0, nvalid; };
template <int NP> struct GroupOrder {
    int G, c, c0, c1, c2, c3, m1, m2, m3, m4;
    __device__ void init(int G_, int c_, const int* cntp) { G = G_; c = c_;
        c0 = __builtin_amdgcn_readfirstlane(cntp[0]); c1 = __builtin_amdgcn_readfirstlane(cntp[1]); c2 = __builtin_amdgcn_readfirstlane(cntp[2]); c3 = __builtin_amdgcn_readfirstlane(cntp[3]);
        m1 = (c0 + 255) >> 8; m2 = m1 + ((c1 + 255) >> 8); m3 = m2 + ((c2 + 255) >> 8); m4 = m3 + ((c3 + 255) >> 8); }
    __device__ bool next(int i, GUnit& u) const {
        const int L = i * G + c; if (L >= m4 * NP) return false;
        const int R = L / NP; u.pn = L % NP;
        const int b1 = (R >= m1) ? 1 : 0, b2 = (R >= m2) ? 1 : 0, b3 = (R >= m3) ? 1 : 0;
        const int g = b1 + b2 + b3, cg = b1 * m1 + b2 * (m2 - m1) + b3 * (m3 - m2), ng = c0 + b1 * (c1 - c0) + b2 * (c2 - c1) + b3 * (c3 - c2);
        u.g = g; u.rt = R - cg; u.row0 = R * 256; const int rem = ng - u.rt * 256; u.nvalid = rem < 256 ? rem : 256; return true;
    }
};
template <class Epi, int NP, int K, int LDA, int LDB, bool GATHER, class Bsel>
__device__ __forceinline__ void gemm_phase_g(int WV_, LAS unsigned char* lds, const bf16_t* Abase, const int* idx, const GroupOrder<NP>& S, const Bsel& bsel, const Epi& E) {
    const int tid = otid(), wid = __builtin_amdgcn_readfirstlane(tid >> 6), lane = tid & 63, wr = wid >> 2, wc = wid & 3, fr = lane & 15, fq = lane >> 4;
    constexpr int nt = K / BK;
    int Rs, Cs; stage_rc(tid * 16, Rs, Cs);
    unsigned voffB[2];
#pragma unroll
    for (int i = 0; i < 2; ++i) { const int R = Rs + 64 * i; const int Rb = Epi::PERM ? ((R & ~31) + perm32(R & 31)) : R; voffB[i] = (unsigned)(Rb * LDB + Cs) * 2u; }
    constexpr size_t kstep = (size_t)(BK * 2);
    constexpr size_t hstepB = (size_t)HALF * LDB * 2;
    const unsigned ldsw = (unsigned)wid * 1024u;
    const int aoff = lds_byte(wr * 64 + fr, fq * 8), boff = lds_byte(wc * 32 + fr, fq * 8);
#define PG8_SA(b, h) (((b) * 2 + (h)) * HTB)
#define PG8_SB(b, h) ((4 + (b) * 2 + (h)) * HTB)
#define PG8_STAGE(bufoff, gbase, voff) do { _Pragma("unroll") for (int _i = 0; _i < 2; ++_i) \
        __builtin_amdgcn_global_load_lds((const unsigned*)((const char*)(gbase) + (voff)[_i]), (LAS unsigned*)(lds + (bufoff) + ldsw + _i * 8192), 16, 0, 0); } while (0)
#define PG8_LDA(dst, b, h) do { _Pragma("unroll") for (int m = 0; m < 4; ++m) _Pragma("unroll") for (int k = 0; k < 2; ++k) dst[m][k] = *(const LAS bf16x8*)(lds + PG8_SA(b, h) + aoff + m * 2048 + k * 1024); } while (0)
#define PG8_LDB(dst, b, h) do { _Pragma("unroll") for (int n = 0; n < 2; ++n) _Pragma("unroll") for (int k = 0; k < 2; ++k) dst[n][k] = *(const LAS bf16x8*)(lds + PG8_SB(b, h) + boff + n * 2048 + k * 1024); } while (0)
#define PG8_MMA(ai, bj, At, Bt) do { __builtin_amdgcn_s_setprio(1); _Pragma("unroll") for (int m = 0; m < 4; ++m) _Pragma("unroll") for (int n = 0; n < 2; ++n) _Pragma("unroll") for (int k = 0; k < 2; ++k) \
        acc[ai][bj][m][n] = __builtin_amdgcn_mfma_f32_16x16x32_bf16(Bt[n][k], At[m][k], acc[ai][bj][m][n], 0, 0, 0); __builtin_amdgcn_s_setprio(0); } while (0)
#define PG8_WAIT_V(n) asm volatile("s_waitcnt vmcnt(" #n ")" ::: "memory")
#define PG8_WAIT_L(n) asm volatile("s_waitcnt lgkmcnt(" #n ")" ::: "memory")
#define PG8_BAR __builtin_amdgcn_s_barrier()
#define PG8_SCHED __builtin_amdgcn_sched_barrier(0)
#define PG8_AOFFS(dst, u) do { _Pragma("unroll") for (int _h = 0; _h < 2; ++_h) _Pragma("unroll") for (int _i = 0; _i < 2; ++_i) { const int _r = 128 * _h + Rs + 64 * _i; \
        if (GATHER) { const int _p = (u).rt * 256 + _r; const int _tok = (_r < (u).nvalid) ? idx[(u).g * T + _p] : 0; dst[_h][_i] = (unsigned)(_tok * LDA + Cs) * 2u; } \
        else dst[_h][_i] = (unsigned)(((u).row0 + _r) * LDA + Cs) * 2u; } } while (0)
    GUnit cur, nxt; int ui = 0;
    if (!S.next(0, cur)) return;
    f32x4 acc[2][2][4][2];
#pragma unroll
    for (int a = 0; a < 2; ++a)
#pragma unroll
        for (int b = 0; b < 2; ++b)
#pragma unroll
            for (int m = 0; m < 4; ++m)
#pragma unroll
                for (int n = 0; n < 2; ++n) acc[a][b][m][n] = (f32x4){0.f, 0.f, 0.f, 0.f};
    bf16x8 At[4][2], B0[2][2], B1[2][2];
    unsigned vo[2][2], nvo[2][2];
    PG8_AOFFS(vo, cur);
    const char* gA = (const char*)Abase; const char* cB = bsel(cur);
    PG8_STAGE(PG8_SB(0, 0), cB, voffB); PG8_STAGE(PG8_SA(0, 0), gA, vo[0]); PG8_STAGE(PG8_SB(0, 1), cB + hstepB, voffB); PG8_STAGE(PG8_SA(0, 1), gA, vo[1]);
    if (wr == 1) PG8_BAR;
    PG8_WAIT_V(4); PG8_BAR;
    PG8_STAGE(PG8_SB(1, 0), cB + kstep, voffB); PG8_STAGE(PG8_SA(1, 0), gA + kstep, vo[0]); PG8_STAGE(PG8_SB(1, 1), cB + hstepB + kstep, voffB);
    PG8_WAIT_V(6); PG8_BAR;
    for (;;) {
        const bool has_next = S.next(ui + 1, nxt);
        if (has_next) { PG8_AOFFS(nvo, nxt); } else {
#pragma unroll
            for (int _h = 0; _h < 2; ++_h)
#pragma unroll
                for (int _i = 0; _i < 2; ++_i) nvo[_h][_i] = vo[_h][_i]; }
        const char* nB = has_next ? bsel(nxt) : cB;
        for (int t = 0; t < nt; t += 2) {
            const bool last = (t == nt - 2);
            const char* a1 = gA + (size_t)(t + 1) * kstep;
            const char* a2 = last ? gA : gA + (size_t)(t + 2) * kstep; const char* b2 = last ? nB : cB + (size_t)(t + 2) * kstep;
            const char* a3 = a2 + kstep; const char* b3 = b2 + kstep;
            unsigned v0[2], v1[2];
            v0[0] = last ? nvo[0][0] : vo[0][0]; v0[1] = last ? nvo[0][1] : vo[0][1]; v1[0] = last ? nvo[1][0] : vo[1][0]; v1[1] = last ? nvo[1][1] : vo[1][1];
            PG8_LDB(B0, 0, 0); PG8_SCHED; PG8_LDA(At, 0, 0); PG8_STAGE(PG8_SA(1, 1), a1, vo[1]);
            PG8_WAIT_L(8); PG8_BAR; PG8_WAIT_L(0); PG8_MMA(0, 0, At, B0); PG8_BAR; PG8_SCHED;
            PG8_LDB(B1, 0, 1); PG8_STAGE(PG8_SB(0, 0), b2, voffB);
            PG8_BAR; PG8_WAIT_L(0); PG8_MMA(0, 1, At, B1); PG8_BAR;
            PG8_LDA(At, 0, 1); PG8_STAGE(PG8_SA(0, 0), a2, v0);
            PG8_BAR; PG8_WAIT_L(0); PG8_MMA(1, 0, At, B0); PG8_BAR; PG8_SCHED;
            PG8_STAGE(PG8_SB(0, 1), b2 + hstepB, voffB);
            PG8_WAIT_V(6); PG8_BAR; PG8_MMA(1, 1, At, B1); PG8_BAR;
            PG8_LDB(B0, 1, 0); PG8_SCHED; PG8_LDA(At, 1, 0); PG8_STAGE(PG8_SA(0, 1), a2, v1);
            PG8_WAIT_L(8); PG8_BAR; PG8_WAIT_L(0); PG8_MMA(0, 0, At, B0); PG8_BAR; PG8_SCHED;
            PG8_LDB(B1, 1, 1); PG8_STAGE(PG8_SB(1, 0), b3, voffB);
            PG8_BAR; PG8_WAIT_L(0); PG8_MMA(0, 1, At, B1); PG8_BAR;
            PG8_LDA(At, 1, 1); PG8_STAGE(PG8_SA(1, 0), a3, v0);
            PG8_BAR; PG8_WAIT_L(0); PG8_MMA(1, 0, At, B0); PG8_BAR; PG8_SCHED;
            PG8_STAGE(PG8_SB(1, 1), b3 + hstepB, voffB);
            PG8_WAIT_V(6); PG8_BAR; PG8_MMA(1, 1, At, B1); PG8_BAR;
        }
        E(acc, cur, wr, wc, fr, fq);
        if (!has_next) break;
#pragma unroll
        for (int a = 0; a < 2; ++a)
#pragma unroll
            for (int b = 0; b < 2; ++b)
#pragma unroll
                for (int m = 0; m < 4; ++m)
#pragma unroll
                    for (int n = 0; n < 2; ++n) acc[a][b][m][n] = (f32x4){0.f, 0.f, 0.f, 0.f};
        cur = nxt; cB = nB; ++ui;
#pragma unroll
        for (int _h = 0; _h < 2; ++_h)
#pragma unroll
            for (int _i = 0; _i < 2; ++_i) vo[_h][_i] = nvo[_h][_i];
    }
    PG8_WAIT_V(0);
    if (wr == 0) PG8_BAR;
    PG8_BAR;
#undef PG8_AOFFS
#undef PG8_SA
#undef PG8_SB
#undef PG8_STAGE
#undef PG8_LDA
#undef PG8_LDB
#undef PG8_MMA
#undef PG8_WAIT_V
#undef PG8_WAIT_L
#undef PG8_BAR
#undef PG8_SCHED
}
struct MUnit { int kind, pn, g, rt, row0, nvalid; };
struct MoeOrder {
    int G, c, c0, c1, c2, c3, m1, m2, m3, m4, ua, nup, da, ntot;
    __device__ void init(int G_, int c_, const int* cntp) { G = G_; c = c_;
        c0 = __builtin_amdgcn_readfirstlane(cntp[0]); c1 = __builtin_amdgcn_readfirstlane(cntp[1]); c2 = __builtin_amdgcn_readfirstlane(cntp[2]); c3 = __builtin_amdgcn_readfirstlane(cntp[3]);
        m1 = (c0 + 255) >> 8; m2 = m1 + ((c1 + 255) >> 8); m3 = m2 + ((c2 + 255) >> 8); m4 = m3 + ((c3 + 255) >> 8); ua = 0; nup = 0; da = 0; ntot = 0; }
    __device__ void range(int ua_, int ub_, int da_, int db_) { ua = ua_; nup = (ub_ - ua_) * 8; da = da_; ntot = nup + (db_ - da_) * 4; }
    __device__ bool next(int i, MUnit& u) const {
        int L = i * G + c; if (L >= ntot) return false;
        const int kind = (L >= nup) ? 1 : 0; L -= kind * nup;
        const int R = kind ? da + (L >> 2) : ua + (L >> 3); u.kind = kind; u.pn = kind ? (L & 3) : (L & 7);
        const int b1 = (R >= m1) ? 1 : 0, b2 = (R >= m2) ? 1 : 0, b3 = (R >= m3) ? 1 : 0;
        const int g = b1 + b2 + b3, cg = b1 * m1 + b2 * (m2 - m1) + b3 * (m3 - m2), ng = c0 + b1 * (c1 - c0) + b2 * (c2 - c1) + b3 * (c3 - c2);
        u.g = g; u.rt = R - cg; u.row0 = R * 256; const int rem = ng - u.rt * 256; u.nvalid = rem < 256 ? rem : 256; return true;
    }
};
template <class EpiU, class EpiD, int K, int LDA, int LDB, class Bsel>
__device__ __forceinline__ void gemm_phase_moe(int WV_, LAS unsigned char* lds, const bf16_t* Aup, const bf16_t* Adn, const int* idx, const MoeOrder& S, const Bsel& bsel, const EpiU& EU, const EpiD& ED) {
    const int tid = otid(), wid = __builtin_amdgcn_readfirstlane(tid >> 6), lane = tid & 63, wr = wid >> 2, wc = wid & 3, fr = lane & 15, fq = lane >> 4;
    constexpr int nt = K / BK;
    unsigned voffB[2];
#pragma unroll
    for (int i = 0; i < 2; ++i) { int Rs, Cs; stage_rc(tid * 16, Rs, Cs); const int R = Rs + 64 * i; const int Rb = (R & ~31) + perm32(R & 31); voffB[i] = (unsigned)(Rb * LDB + Cs) * 2u; }
    constexpr size_t kstep = (size_t)(BK * 2);
    constexpr size_t hstepB = (size_t)HALF * LDB * 2;
    const unsigned ldsw = (unsigned)wid * 1024u;
    const int aoff = lds_byte(wr * 64 + fr, fq * 8), boff = lds_byte(wc * 32 + fr, fq * 8);
#define PG8_SA(b, h) (((b) * 2 + (h)) * HTB)
#define PG8_SB(b, h) ((4 + (b) * 2 + (h)) * HTB)
#define PG8_STAGE(bufoff, gbase, voff) do { _Pragma("unroll") for (int _i = 0; _i < 2; ++_i) \
        __builtin_amdgcn_global_load_lds((const unsigned*)((const char*)(gbase) + (voff)[_i]), (LAS unsigned*)(lds + (bufoff) + ldsw + _i * 8192), 16, 0, 0); } while (0)
#define PG8_LDA(dst, b, h) do { _Pragma("unroll") for (int m = 0; m < 4; ++m) _Pragma("unroll") for (int k = 0; k < 2; ++k) dst[m][k] = *(const LAS bf16x8*)(lds + PG8_SA(b, h) + aoff + m * 2048 + k * 1024); } while (0)
#define PG8_LDB(dst, b, h) do { _Pragma("unroll") for (int n = 0; n < 2; ++n) _Pragma("unroll") for (int k = 0; k < 2; ++k) dst[n][k] = *(const LAS bf16x8*)(lds + PG8_SB(b, h) + boff + n * 2048 + k * 1024); } while (0)
#define PG8_MMA(ai, bj, At, Bt) do { __builtin_amdgcn_s_setprio(1); _Pragma("unroll") for (int m = 0; m < 4; ++m) _Pragma("unroll") for (int n = 0; n < 2; ++n) _Pragma("unroll") for (int k = 0; k < 2; ++k) \
        acc[ai][bj][m][n] = __builtin_amdgcn_mfma_f32_16x16x32_bf16(Bt[n][k], At[m][k], acc[ai][bj][m][n], 0, 0, 0); __builtin_amdgcn_s_setprio(0); } while (0)
#define PG8_WAIT_V(n) asm volatile("s_waitcnt vmcnt(" #n ")" ::: "memory")
#define PG8_WAIT_L(n) asm volatile("s_waitcnt lgkmcnt(" #n ")" ::: "memory")
#define PG8_BAR __builtin_amdgcn_s_barrier()
#define PG8_SCHED __builtin_amdgcn_sched_barrier(0)
#define PG8_AOFFS(dst, u) do { int Rs, Cs; stage_rc(otid() * 16, Rs, Cs); _Pragma("unroll") for (int _h = 0; _h < 2; ++_h) _Pragma("unroll") for (int _i = 0; _i < 2; ++_i) { const int _r = 128 * _h + Rs + 64 * _i; \
        if ((u).kind == 0) { const int _p = (u).rt * 256 + _r; const int _tok = (_r < (u).nvalid) ? idx[(u).g * T + _p] : 0; dst[_h][_i] = (unsigned)(_tok * LDA + Cs) * 2u; } \
        else dst[_h][_i] = (unsigned)(((u).row0 + _r) * LDA + Cs) * 2u; } } while (0)
    MUnit cur, nxt; int ui = 0;
    if (!S.next(0, cur)) return;
    f32x4 acc[2][2][4][2];
#pragma unroll
    for (int a = 0; a < 2; ++a)
#pragma unroll
        for (int b = 0; b < 2; ++b)
#pragma unroll
            for (int m = 0; m < 4; ++m)
#pragma unroll
                for (int n = 0; n < 2; ++n) acc[a][b][m][n] = (f32x4){0.f, 0.f, 0.f, 0.f};
    bf16x8 At[4][2], B0[2][2], B1[2][2];
    unsigned vo[2][2], nvo[2][2];
    PG8_AOFFS(vo, cur);
    const char* gA = (const char*)(cur.kind ? Adn : Aup); const char* cB = bsel(cur);
    PG8_STAGE(PG8_SB(0, 0), cB, voffB); PG8_STAGE(PG8_SA(0, 0), gA, vo[0]); PG8_STAGE(PG8_SB(0, 1), cB + hstepB, voffB); PG8_STAGE(PG8_SA(0, 1), gA, vo[1]);
    if (wr == 1) PG8_BAR;
    PG8_WAIT_V(4); PG8_BAR;
    PG8_STAGE(PG8_SB(1, 0), cB + kstep, voffB); PG8_STAGE(PG8_SA(1, 0), gA + kstep, vo[0]); PG8_STAGE(PG8_SB(1, 1), cB + hstepB + kstep, voffB);
    PG8_WAIT_V(6); PG8_BAR;
    for (;;) {
        const bool has_next = S.next(ui + 1, nxt);
        if (has_next) { PG8_AOFFS(nvo, nxt); } else {
#pragma unroll
            for (int _h = 0; _h < 2; ++_h)
#pragma unroll
                for (int _i = 0; _i < 2; ++_i) nvo[_h][_i] = vo[_h][_i]; }
        const char* nB = has_next ? bsel(nxt) : cB; const char* nA = has_next ? (const char*)(nxt.kind ? Adn : Aup) : gA;
        for (int t = 0; t < nt; t += 2) {
            const bool last = (t == nt - 2);
            const char* a1 = gA + (size_t)(t + 1) * kstep;
            const char* a2 = last ? nA : gA + (size_t)(t + 2) * kstep; const char* b2 = last ? nB : cB + (size_t)(t + 2) * kstep;
            const char* a3 = a2 + kstep; const char* b3 = b2 + kstep;
            unsigned v0[2], v1[2];
            v0[0] = last ? nvo[0][0] : vo[0][0]; v0[1] = last ? nvo[0][1] : vo[0][1]; v1[0] = last ? nvo[1][0] : vo[1][0]; v1[1] = last ? nvo[1][1] : vo[1][1];
            PG8_LDB(B0, 0, 0); PG8_SCHED; PG8_LDA(At, 0, 0); PG8_STAGE(PG8_SA(1, 1), a1, vo[1]);
            PG8_WAIT_L(8); PG8_BAR; PG8_WAIT_L(0); PG8_MMA(0, 0, At, B0); PG8_BAR; PG8_SCHED;
            PG8_LDB(B1, 0, 1); PG8_STAGE(PG8_SB(0, 0), b2, voffB);
            PG8_BAR; PG8_WAIT_L(0); PG8_MMA(0, 1, At, B1); PG8_BAR;
            PG8_LDA(At, 0, 1); PG8_STAGE(PG8_SA(0, 0), a2, v0);
            PG8_BAR; PG8_WAIT_L(0); PG8_MMA(1, 0, At, B0); PG8_BAR; PG8_SCHED;
            PG8_STAGE(PG8_SB(0, 1), b2 + hstepB, voffB);
            PG8_WAIT_V(6); PG8_BAR; PG8_MMA(1, 1, At, B1); PG8_BAR;
            PG8_LDB(B0, 1, 0); PG8_SCHED; PG8_LDA(At, 1, 0); PG8_STAGE(PG8_SA(0, 1), a2, v1);
            PG8_WAIT_L(8); PG8_BAR; PG8_WAIT_L(0); PG8_MMA(0, 0, At, B0); PG8_BAR; PG8_SCHED;
            PG8_LDB(B1, 1, 1); PG8_STAGE(PG8_SB(1, 0), b3, voffB);
            PG8_BAR; PG8_WAIT_L(0); PG8_MMA(0, 1, At, B1); PG8_BAR;
            PG8_LDA(At, 1, 1); PG8_STAGE(PG8_SA(1, 0), a3, v0);
            PG8_BAR; PG8_WAIT_L(0); PG8_MMA(1, 0, At, B0); PG8_BAR; PG8_SCHED;
            PG8_STAGE(PG8_SB(1, 1), b3 + hstepB, voffB);
            PG8_WAIT_V(6); PG8_BAR; PG8_MMA(1, 1, At, B1); PG8_BAR;
        }
        if (cur.kind == 0) EU(acc, cur, wr, wc, fr, fq); else ED(acc, cur, wr, wc, fr, fq);
        if (!has_next) break;
#pragma unroll
        for (int a = 0; a < 2; ++a)
#pragma unroll
            for (int b = 0; b < 2; ++b)
#pragma unroll
                for (int m = 0; m < 4; ++m)
#pragma unroll
                    for (int n = 0; n < 2; ++n) acc[a][b][m][n] = (f32x4){0.f, 0.f, 0.f, 0.f};
        cur = nxt; cB = nB; gA = nA; ++ui;
#pragma unroll
        for (int _h = 0; _h < 2; ++_h)
#pragma unroll
            for (int _i = 0; _i < 2; ++_i) vo[_h][_i] = nvo[_h][_i];
    }
    PG8_WAIT_V(0);
    if (wr == 0) PG8_BAR;
    PG8_BAR;
#undef PG8_AOFFS
#undef PG8_SA
#undef PG8_SB
#undef PG8_STAGE
#undef PG8_LDA
#undef PG8_LDB
#undef PG8_MMA
#undef PG8_WAIT_V
#undef PG8_WAIT_L
#undef PG8_BAR
#undef PG8_SCHED
}
struct EpiMoeUpG {
    static constexpr bool PERM = true;
    bf16_t* H; const float* gs; const int* idx; const float* rstd;
    template <class U> __device__ __forceinline__ void operator()(const f32x4 (&acc)[2][2][4][2], const U& u, int wr, int wc, int fr, int fq) const {
        const int r0 = wr * 64 + fr, col0 = u.pn * HALF + wc * 32 + 8 * fq, el = u.pn >> 1;
#pragma unroll
        for (int ai = 0; ai < 2; ++ai)
#pragma unroll
            for (int m = 0; m < 4; ++m) { const int r = r0 + ai * HALF + m * 16; const bool ok = r < u.nvalid; const size_t slot = (size_t)u.g * T + u.rt * 256 + r;
                const float gw = ok ? gs[slot * 4 + el] : 0.f, rs = ok ? rstd[slot] : 0.f;
                float o[8];
#pragma unroll
                for (int n = 0; n < 2; ++n)
#pragma unroll
                    for (int j = 0; j < 4; ++j) o[4 * n + j] = siluf_(acc[ai][0][m][n][j] * rs) * (acc[ai][1][m][n][j] * rs) * gw;
                *(u32x4*)(H + (size_t)(u.row0 + r) * 1024 + col0) = pack8(o); }
    }
};
struct EpiMoeDownG {
    static constexpr bool PERM = true;
    float* OUT; const int* idx; bf16_t* HB; float* ss;
    template <class U> __device__ __forceinline__ void operator()(const f32x4 (&acc)[2][2][4][2], const U& u, int wr, int wc, int fr, int fq) const {
        const int r0 = wr * 64 + fr, col0 = u.pn * BM + wc * 32 + 8 * fq;
#pragma unroll
        for (int ai = 0; ai < 2; ++ai)
#pragma unroll
            for (int m = 0; m < 4; ++m) { const int r = r0 + ai * HALF + m * 16; const bool ok = r < u.nvalid; float sq = 0.f; int tok = 0;
                if (ok) { tok = idx[u.g * T + u.rt * 256 + r];
#pragma unroll
                    for (int bj = 0; bj < 2; ++bj) { bf16_t* ph = HB + (size_t)tok * D + col0 + bj * HALF; float o[8]; unpack8(*(const u32x4*)ph, o);
#pragma unroll
                        for (int j = 0; j < 4; ++j) { o[j] += acc[ai][bj][m][0][j]; o[4 + j] += acc[ai][bj][m][1][j]; }
#pragma unroll
                        for (int j = 0; j < 8; ++j) sq += o[j] * o[j];
                        *(u32x4*)ph = pack8(o);
                        if (OUT) { float* p = OUT + (size_t)tok * D + col0 + bj * HALF; *(f32x4*)p = (f32x4){o[0], o[1], o[2], o[3]}; *(f32x4*)(p + 4) = (f32x4){o[4], o[5], o[6], o[7]}; } } }
                sq = sum_rows(sq);
                if (ok && fq == 0 && ss) ss[(size_t)tok * 16 + u.pn * 4 + wc] = sq; }
    }
};
struct MUnit2 { int kind, pn, q, rt, row0, nvalid;
    __device__ __forceinline__ int g() const { return q / 6; }
    __device__ __forceinline__ int elo() const { const int p = q - 6 * (q / 6); return ((p >= 3) ? 1 : 0) + ((p >= 5) ? 1 : 0); }
    __device__ __forceinline__ int ehi() const { const int p = q - 6 * (q / 6); return p + 1 - ((p >= 3) ? 2 : 0) - ((p >= 5) ? 1 : 0); } };
constexpr int MOE_TAB = 131072;
struct MoeOrder2 {
    int G, c, mtot, ua, nup, da, ntot; const LAS int* tab;
    __device__ __forceinline__ void init(int G_, int c_, const int* cntp, int lane, LAS unsigned char* lds) { G = G_; c = ((G_ & 7) == 0) ? (c_ & 7) * (G_ >> 3) + (c_ >> 3) : c_;
        LAS int* tw = (LAS int*)(lds + MOE_TAB); tab = tw;
        const int cntv = (lane < 24) ? cntp[lane] : 0; int pmv = 0x7fffffff; int s = 0;
#pragma unroll
        for (int j = 0; j < 24; ++j) { const int cj = __builtin_amdgcn_readlane(cntv, j); if (lane == j) pmv = s; s += (cj + 255) >> 8; }
        if (lane < 32) { tw[lane] = pmv; tw[32 + lane] = cntv; }
        mtot = s; ua = 0; nup = 0; da = 0; ntot = 0; }
    __device__ __forceinline__ void range(int ua_, int ub_, int da_, int db_) { ua = ua_; nup = (ub_ - ua_) * 4; da = da_; ntot = nup + (db_ - da_) * 4; }
    __device__ __forceinline__ bool next(int i, MUnit2& u) const {
        int Lr = i * G + ((i & 1) ? G - 1 - c : c); if (Lr >= ntot) return false;
        const int kind = (Lr >= nup) ? 1 : 0; Lr -= kind * nup;
        const int R = ua + kind * (da - ua) + (Lr >> 2); u.kind = kind; u.pn = Lr & 3;
        int qv = -1;
#pragma unroll
        for (int j = 0; j < 24; ++j) qv += (tab[j] <= R) ? 1 : 0;
        const int q = __builtin_amdgcn_readfirstlane(qv);
        const int cg = __builtin_amdgcn_readfirstlane(tab[q]), ng = __builtin_amdgcn_readfirstlane(tab[32 + q]);
        u.q = q; u.rt = R - cg; u.row0 = R * 256; const int rem = ng - u.rt * 256; u.nvalid = rem < 256 ? rem : 256; return true;
    }
};
template <class EpiU, class EpiD, class Bsel>
__device__ __forceinline__ void gemm_phase_moe2(int WV_, LAS unsigned char* lds, const bf16_t* Aup, const bf16_t* Adn, const int* idx, const MoeOrder2& S, const Bsel& bsel, const EpiU& EU, const EpiD& ED) {
    const int tid = otid(), wid = __builtin_amdgcn_readfirstlane(tid >> 6), lane = tid & 63, wr = wid >> 2, wc = wid & 3, fr = lane & 15, fq = lane >> 4;
    constexpr int LDB = 1024;
    unsigned voffB[2];
#pragma unroll
    for (int i = 0; i < 2; ++i) { int Rs, Cs; stage_rc(tid * 16, Rs, Cs); const int R = Rs + 64 * i; const int Rb = (R & ~31) + perm32(R & 31); voffB[i] = (unsigned)(Rb * LDB + Cs) * 2u; }
    constexpr size_t kstep = (size_t)(BK * 2);
    constexpr size_t hstepB = (size_t)HALF * LDB * 2;
    const unsigned ldsw = (unsigned)wid * 1024u;
    const int aoff = lds_byte(wr * 64 + fr, fq * 8), boff = lds_byte(wc * 32 + fr, fq * 8);
#define PG8_SA(b, h) (((b) * 2 + (h)) * HTB)
#define PG8_SB(b, h) ((4 + (b) * 2 + (h)) * HTB)
#define PG8_STAGE(bufoff, gbase, voff) do { _Pragma("unroll") for (int _i = 0; _i < 2; ++_i) \
        __builtin_amdgcn_global_load_lds((const unsigned*)((const char*)(gbase) + (voff)[_i]), (LAS unsigned*)(lds + (bufoff) + ldsw + _i * 8192), 16, 0, 0); } while (0)
#define PG8_LDA(dst, b, h) do { _Pragma("unroll") for (int m = 0; m < 4; ++m) _Pragma("unroll") for (int k = 0; k < 2; ++k) dst[m][k] = *(const LAS bf16x8*)(lds + PG8_SA(b, h) + aoff + m * 2048 + k * 1024); } while (0)
#define PG8_LDB(dst, b, h) do { _Pragma("unroll") for (int n = 0; n < 2; ++n) _Pragma("unroll") for (int k = 0; k < 2; ++k) dst[n][k] = *(const LAS bf16x8*)(lds + PG8_SB(b, h) + boff + n * 2048 + k * 1024); } while (0)
#define PG8_MMA(ai, bj, At, Bt) do { __builtin_amdgcn_s_setprio(1); _Pragma("unroll") for (int m = 0; m < 4; ++m) _Pragma("unroll") for (int n = 0; n < 2; ++n) _Pragma("unroll") for (int k = 0; k < 2; ++k) \
        acc[ai][bj][m][n] = __builtin_amdgcn_mfma_f32_16x16x32_bf16(Bt[n][k], At[m][k], acc[ai][bj][m][n], 0, 0, 0); __builtin_amdgcn_s_setprio(0); } while (0)
#define PG8_WAIT_V(n) asm volatile("s_waitcnt vmcnt(" #n ")" ::: "memory")
#define PG8_WAIT_L(n) asm volatile("s_waitcnt lgkmcnt(" #n ")" ::: "memory")
#define PG8_BAR __builtin_amdgcn_s_barrier()
#define PG8_SCHED __builtin_amdgcn_sched_barrier(0)
#define PG8_AOFFS(dst, u) do { int Rs, Cs; stage_rc(otid() * 16, Rs, Cs); _Pragma("unroll") for (int _h = 0; _h < 2; ++_h) _Pragma("unroll") for (int _i = 0; _i < 2; ++_i) { const int _r = 128 * _h + Rs + 64 * _i; \
        if ((u).kind == 0) { const int _p = (u).rt * 256 + _r; const int _tok = (_r < (u).nvalid) ? idx[(u).q * T + _p] : 0; dst[_h][_i] = (unsigned)(_tok * 1024 + Cs) * 2u; } \
        else dst[_h][_i] = (unsigned)(((u).row0 + _r) * 512 + Cs) * 2u; } } while (0)
    MUnit2 cur, nxt; int ui = 0;
    if (!S.next(0, cur)) return;
    f32x4 acc[2][2][4][2];
#pragma unroll
    for (int a = 0; a < 2; ++a)
#pragma unroll
        for (int b = 0; b < 2; ++b)
#pragma unroll
            for (int m = 0; m < 4; ++m)
#pragma unroll
                for (int n = 0; n < 2; ++n) acc[a][b][m][n] = (f32x4){0.f, 0.f, 0.f, 0.f};
    bf16x8 At[4][2], B0[2][2], B1[2][2];
    unsigned vo[2][2], nvo[2][2];
    PG8_AOFFS(vo, cur);
    const char* gA = (const char*)(cur.kind ? Adn : Aup); const char* cB = bsel(cur);
    PG8_STAGE(PG8_SB(0, 0), cB, voffB); PG8_STAGE(PG8_SA(0, 0), gA, vo[0]); PG8_STAGE(PG8_SB(0, 1), cB + hstepB, voffB); PG8_STAGE(PG8_SA(0, 1), gA, vo[1]);
    if (wr == 1) PG8_BAR;
    PG8_WAIT_V(4); PG8_BAR;
    PG8_STAGE(PG8_SB(1, 0), cB + kstep, voffB); PG8_STAGE(PG8_SA(1, 0), gA + kstep, vo[0]); PG8_STAGE(PG8_SB(1, 1), cB + hstepB + kstep, voffB);
    PG8_WAIT_V(6); PG8_BAR;
    for (;;) {
        const bool has_next = S.next(ui + 1, nxt);
        if (has_next) { PG8_AOFFS(nvo, nxt); } else {
#pragma unroll
            for (int _h = 0; _h < 2; ++_h)
#pragma unroll
                for (int _i = 0; _i < 2; ++_i) nvo[_h][_i] = vo[_h][_i]; }
        const char* nB = has_next ? bsel(nxt) : cB; const char* nA = has_next ? (const char*)(nxt.kind ? Adn : Aup) : gA;
        const int ntc = __builtin_amdgcn_readfirstlane(16 - 8 * cur.kind);
        const size_t jmp = (size_t)(cur.kind * (cur.ehi() - cur.elo() - 1) * 512);
        for (int t = 0; t < ntc; t += 2) {
            const bool last = (t == ntc - 2);
            const char* a1 = gA + (size_t)(t + 1) * kstep;
            const char* a2 = last ? nA : gA + (size_t)(t + 2) * kstep; const char* b2 = last ? nB : cB + (size_t)(t + 2) * kstep + ((t + 2 >= 4) ? jmp : (size_t)0);
            const char* a3 = a2 + kstep; const char* b3 = b2 + kstep;
            unsigned v0[2], v1[2];
            v0[0] = last ? nvo[0][0] : vo[0][0]; v0[1] = last ? nvo[0][1] : vo[0][1]; v1[0] = last ? nvo[1][0] : vo[1][0]; v1[1] = last ? nvo[1][1] : vo[1][1];
            PG8_LDB(B0, 0, 0); PG8_SCHED; PG8_LDA(At, 0, 0); PG8_STAGE(PG8_SA(1, 1), a1, vo[1]);
            PG8_WAIT_L(8); PG8_BAR; PG8_WAIT_L(0); PG8_MMA(0, 0, At, B0); PG8_BAR; PG8_SCHED;
            PG8_LDB(B1, 0, 1); PG8_STAGE(PG8_SB(0, 0), b2, voffB);
            PG8_BAR; PG8_WAIT_L(0); PG8_MMA(0, 1, At, B1); PG8_BAR;
            PG8_LDA(At, 0, 1); PG8_STAGE(PG8_SA(0, 0), a2, v0);
            PG8_BAR; PG8_WAIT_L(0); PG8_MMA(1, 0, At, B0); PG8_BAR; PG8_SCHED;
            PG8_STAGE(PG8_SB(0, 1), b2 + hstepB, voffB);
            PG8_WAIT_V(6); PG8_BAR; PG8_MMA(1, 1, At, B1); PG8_BAR;
            PG8_LDB(B0, 1, 0); PG8_SCHED; PG8_LDA(At, 1, 0); PG8_STAGE(PG8_SA(0, 1), a2, v1);
            PG8_WAIT_L(8); PG8_BAR; PG8_WAIT_L(0); PG8_MMA(0, 0, At, B0); PG8_BAR; PG8_SCHED;
            PG8_LDB(B1, 1, 1); PG8_STAGE(PG8_SB(1, 0), b3, voffB);
            PG8_BAR; PG8_WAIT_L(0); PG8_MMA(0, 1, At, B1); PG8_BAR;
            PG8_LDA(At, 1, 1); PG8_STAGE(PG8_SA(1, 0), a3, v0);
            PG8_BAR; PG8_WAIT_L(0); PG8_MMA(1, 0, At, B0); PG8_BAR; PG8_SCHED;
            PG8_STAGE(PG8_SB(1, 1), b3 + hstepB, voffB);
            PG8_WAIT_V(6); PG8_BAR; PG8_MMA(1, 1, At, B1); PG8_BAR;
        }
        if (cur.kind == 0) EU(acc, cur, wr, wc, fr, fq); else ED(acc, cur, wr, wc, fr, fq);
        if (!has_next) break;
#pragma unroll
        for (int a = 0; a < 2; ++a)
#pragma unroll
            for (int b = 0; b < 2; ++b)
#pragma unroll
                for (int m = 0; m < 4; ++m)
#pragma unroll
                    for (int n = 0; n < 2; ++n) acc[a][b][m][n] = (f32x4){0.f, 0.f, 0.f, 0.f};
        cur = nxt; cB = nB; gA = nA; ++ui;
#pragma unroll
        for (int _h = 0; _h < 2; ++_h)
#pragma unroll
            for (int _i = 0; _i < 2; ++_i) vo[_h][_i] = nvo[_h][_i];
    }
    PG8_WAIT_V(0);
    if (wr == 0) PG8_BAR;
    PG8_BAR;
#undef PG8_AOFFS
#undef PG8_SA
#undef PG8_SB
#undef PG8_STAGE
#undef PG8_LDA
#undef PG8_LDB
#undef PG8_MMA
#undef PG8_WAIT_V
#undef PG8_WAIT_L
#undef PG8_BAR
#undef PG8_SCHED
}
struct EpiMoeUpP {
    static constexpr bool PERM = true;
    bf16_t* H; const float* gs; const float* rstd;
    template <class U> __device__ __forceinline__ void operator()(const f32x4 (&acc)[2][2][4][2], const U& u, int wr, int wc, int fr, int fq) const {
        const int r0 = wr * 64 + fr, col0 = u.pn * HALF + wc * 32 + 8 * fq, el = u.pn >> 1;
        float gwv[2][4], rsv[2][4];
#pragma unroll
        for (int ai = 0; ai < 2; ++ai)
#pragma unroll
            for (int m = 0; m < 4; ++m) { const int r = r0 + ai * HALF + m * 16; const bool ok = r < u.nvalid; const size_t slot = (size_t)u.q * T + u.rt * 256 + r;
                gwv[ai][m] = ok ? gs[slot * 2 + el] : 0.f; rsv[ai][m] = ok ? rstd[slot] : 0.f; }
        __builtin_amdgcn_sched_barrier(0);
#pragma unroll
        for (int ai = 0; ai < 2; ++ai)
#pragma unroll
            for (int m = 0; m < 4; ++m) { const int r = r0 + ai * HALF + m * 16; const float gw = gwv[ai][m], rs = rsv[ai][m];
                float o[8];
#pragma unroll
                for (int n = 0; n < 2; ++n)
#pragma unroll
                    for (int j = 0; j < 4; ++j) o[4 * n + j] = siluf_(acc[ai][0][m][n][j] * rs) * (acc[ai][1][m][n][j] * rs) * gw;
                *(u32x4*)(H + (size_t)(u.row0 + r) * 512 + col0) = pack8(o); }
    }
};
struct EpiMoeDownP {
    static constexpr bool PERM = true;
    float* OUT; const int* idx; bf16_t* HB; float* ss;
    template <class U> __device__ __forceinline__ void operator()(const f32x4 (&acc)[2][2][4][2], const U& u, int wr, int wc, int fr, int fq) const {
        const int r0 = wr * 64 + fr, col0 = u.pn * BM + wc * 32 + 8 * fq;
        int tok[2][4];
#pragma unroll
        for (int ai = 0; ai < 2; ++ai)
#pragma unroll
            for (int m = 0; m < 4; ++m) { const int r = r0 + ai * HALF + m * 16; tok[ai][m] = (r < u.nvalid) ? idx[u.q * T + u.rt * 256 + r] : -1; }
#pragma unroll
        for (int ai = 0; ai < 2; ++ai) {
            u32x4 old[4][2];
#pragma unroll
            for (int m = 0; m < 4; ++m)
#pragma unroll
                for (int bj = 0; bj < 2; ++bj) old[m][bj] = *(const u32x4*)(HB + (size_t)(tok[ai][m] < 0 ? 0 : tok[ai][m]) * D + col0 + bj * HALF);
            __builtin_amdgcn_sched_barrier(0);
#pragma unroll
            for (int m = 0; m < 4; ++m) { const bool ok = tok[ai][m] >= 0; float sq = 0.f;
                if (ok) {
#pragma unroll
                    for (int bj = 0; bj < 2; ++bj) { bf16_t* ph = HB + (size_t)tok[ai][m] * D + col0 + bj * HALF; float o[8]; unpack8(old[m][bj], o);
#pragma unroll
                        for (int j = 0; j < 4; ++j) { o[j] += acc[ai][bj][m][0][j]; o[4 + j] += acc[ai][bj][m][1][j]; }
#pragma unroll
                        for (int j = 0; j < 8; ++j) sq += o[j] * o[j];
                        if (!OUT) *(u32x4*)ph = pack8(o);
                        if (OUT) { float* p = OUT + (size_t)tok[ai][m] * D + col0 + bj * HALF; *(f32x4*)p = (f32x4){o[0], o[1], o[2], o[3]}; *(f32x4*)(p + 4) = (f32x4){o[4], o[5], o[6], o[7]}; } } }
                sq = sum_rows(sq);
                if (ok && fq == 0 && ss) ss[(size_t)tok[ai][m] * 16 + u.pn * 4 + wc] = sq; }
            __builtin_amdgcn_sched_barrier(0);
        }
    }
};
}

struct Args { const float* in[41]; float* out; unsigned char* ws; int lo, hi; };
constexpr int LDS_SCRATCH = 153600, LDS_BYTES = LDS_SCRATCH + 256;
__device__ __forceinline__ int arg_lohi(const Args& a, int i) { i = __builtin_amdgcn_readfirstlane(i); asm volatile("" : "+s"(i)); return __builtin_amdgcn_readfirstlane((&a.lo)[i]); }
__device__ __forceinline__ const float* inp(const Args& a, int i) { i = __builtin_amdgcn_readfirstlane(i); asm volatile("" : "+s"(i)); return a.in[i]; }

enum { I_X = 0, I_MEM, I_MEMG, I_WMKV, I_NMIX, I_NXA, I_NFFN, I_XWQ, I_XWO, I_XQG, I_XKG, I_WGRP, I_BGRP, I_WEXP, I_BEXP, I_W1, I_W3, I_W2,
       I_EVIN, I_EVOUT, I_GMWS, I_GMBS, I_GMLN, I_LAMRE, I_LAMIM, I_BRE, I_BIM, I_CRE, I_CIM, I_S5D, I_LOGSTEP, I_WGLU, I_BGLU,
       I_ODIN, I_ODOUT, I_CONVW, I_CONVB, I_BIF, I_HNG, I_MBQG, I_MBKG };

struct XI { const float* W; bf16_t* WT; const float* gk; int ldw, ldt, k0, n0, drow0; };
__device__ __forceinline__ void xi_load(const XI& x, int lane, float (&v_)[32]) {
#pragma unroll
    for (int i = 0; i < 32; ++i) { const int kk = 2 * i + (lane >> 5); v_[i] = x.W[(size_t)(x.k0 + kk) * x.ldw + x.n0 + (lane & 31)]; }
}
__device__ __forceinline__ void xi_finish(const XI& x, float (&v_)[32], float* scr, int lane) {
    if (x.gk) {
#pragma unroll
        for (int i = 0; i < 32; ++i) v_[i] *= x.gk[x.k0 + 2 * i + (lane >> 5)]; }
#pragma unroll
    for (int i = 0; i < 32; ++i) { const int kk = 2 * i + (lane >> 5); scr[kk * 33 + (lane & 31)] = v_[i]; }
    asm volatile("s_waitcnt lgkmcnt(0)" ::: "memory");
    const int c = lane & 7;
#pragma unroll
    for (int j = 0; j < 4; ++j) { const int n = (lane >> 3) + 8 * j; const float* sp = scr + (8 * c) * 33 + n;
        u32x4 o; o.x = pk2(sp[0 * 33], sp[1 * 33]); o.y = pk2(sp[2 * 33], sp[3 * 33]); o.z = pk2(sp[4 * 33], sp[5 * 33]); o.w = pk2(sp[6 * 33], sp[7 * 33]);
        *(u32x4*)(x.WT + (size_t)(x.drow0 + n) * x.ldt + x.k0 + 8 * c) = o; }
    asm volatile("s_waitcnt lgkmcnt(0)" ::: "memory");
}
__device__ __forceinline__ XI xi_decode(const Args& a, unsigned char* ws, int it) {
    constexpr int N_MKV = 16 * 64, N_SQ = 16 * 32, N_EXP = 16 * 8, N_W2 = 64 * 32, N_EVIN = 16 * 48, N_GLU = 8 * 16, N_ODIN = 16 * 113;
    constexpr int C0 = N_MKV, C1 = C0 + 4 * N_SQ, C2 = C1 + 4 * N_SQ, C3 = C2 + 64 * N_EXP, C4 = C3 + 64 * N_EXP, C5 = C4 + 4 * N_W2,
                  C6 = C5 + 2 * N_EVIN, C7 = C6 + 2 * N_SQ, C8 = C7 + 2 * N_GLU, C9 = C8 + 2 * N_ODIN;
        if (it < C0) { const int r = it; return XI{inp(a, I_WMKV), (bf16_t*)(ws + WS_WMKV), nullptr, 2048, 1024, 64 * (r / 64), 32 * (r % 64), 32 * (r % 64)}; }
        else if (it < C1) { const int r = it - C0, L = r / N_SQ, q = r % N_SQ; return XI{inp(a, I_XWQ) + (size_t)L * 1024 * 1024, (bf16_t*)(ws + WS_WXQ) + (size_t)L * 1024 * 1024, inp(a, I_NXA) + L * D, 1024, 1024, 64 * (q / 32), 32 * (q % 32), 32 * (q % 32)}; }
        else if (it < C2) { const int r = it - C1, L = r / N_SQ, q = r % N_SQ; return XI{inp(a, I_XWO) + (size_t)L * 1024 * 1024, (bf16_t*)(ws + WS_WXO) + (size_t)L * 1024 * 1024, nullptr, 1024, 1024, 64 * (q / 32), 32 * (q % 32), 32 * (q % 32)}; }
        else if (it < C4) { const bool is3 = it >= C3; const int r = is3 ? it - C3 : it - C2, le = r / N_EXP, q = r % N_EXP, L = le / 16, e = le % 16;
            const int n0 = 32 * (q % 8), hh0 = (e % 8) * 256 + n0, rho0 = 256 * (hh0 / 128) + (hh0 % 128) + (is3 ? 128 : 0);
            return XI{inp(a, is3 ? I_W3 : I_W1) + (size_t)le * 1024 * 256, (bf16_t*)(ws + WS_WUP) + (size_t)(L * 2 + e / 8) * 4096 * 1024, inp(a, I_NFFN) + L * D, 256, 1024, 64 * (q / 8), n0, rho0}; }
        else if (it < C5) { const int r = it - C4, L = r / N_W2, q = r % N_W2; const int kg = 64 * (q / 32);
            return XI{inp(a, I_W2) + (size_t)L * 4096 * 1024 + (size_t)(kg & ~1023) * 1024, (bf16_t*)(ws + WS_WDN) + (size_t)L * 1024 * 4096 + (size_t)(kg >> 10) * 1024 * 1024, nullptr, 1024, 1024, kg & 1023, 32 * (q % 32), 32 * (q % 32)}; }
        else if (it < C6) { const int r = it - C5, j = r / N_EVIN, q = r % N_EVIN; return XI{inp(a, I_EVIN) + (size_t)j * 1024 * 1536, (bf16_t*)(ws + WS_WEVIN) + (size_t)j * 1536 * 1024, inp(a, I_NMIX) + (2 * j) * D, 1536, 1024, 64 * (q / 48), 32 * (q % 48), 32 * (q % 48)}; }
        else if (it < C7) { const int r = it - C6, j = r / N_SQ, q = r % N_SQ; return XI{inp(a, I_EVOUT) + (size_t)j * 1024 * 1024, (bf16_t*)(ws + WS_WEVOUT) + (size_t)j * 1024 * 1024, nullptr, 1024, 1024, 64 * (q / 32), 32 * (q % 32), 32 * (q % 32)}; }
        else if (it < C8) { const int r = it - C7, j = r / N_GLU, q = r % N_GLU; return XI{inp(a, I_WGLU) + (size_t)j * 512 * 512, (bf16_t*)(ws + WS_WGLU) + (size_t)j * 512 * 512, nullptr, 512, 512, 64 * (q / 16), 32 * (q % 16), 32 * (q % 16)}; }
        else if (it < C9) { const int r = it - C8, j = r / N_ODIN, q = r % N_ODIN; const int nb = q % 113, d0 = (nb < 112) ? 32 * nb : 3584, s0 = (nb < 112) ? (d0 < 2048 ? d0 : d0 + 8) : 2048;
            return XI{inp(a, I_ODIN) + (size_t)j * 1024 * ODD_IN, (bf16_t*)(ws + WS_WODIN) + (size_t)j * ODD_NP * 1024, inp(a, I_NMIX) + (2 * j + 1) * D, ODD_IN, 1024, 64 * (q / 113), s0, d0}; }
        else { const int r = it - C9, j = r / N_SQ, q = r % N_SQ; return XI{inp(a, I_ODOUT) + (size_t)j * 1024 * 1024, (bf16_t*)(ws + WS_WODOUT) + (size_t)j * 1024 * 1024, nullptr, 1024, 1024, 64 * (q / 32), 32 * (q % 32), 32 * (q % 32)}; }
}
namespace wc {
constexpr int N_MKV = 16 * 64, N_SQ = 16 * 32, N_EXP = 16 * 8, N_W2 = 64 * 32, N_EVIN = 16 * 48, N_GLU = 8 * 16, N_ODIN = 16 * 113;
constexpr int C0 = N_MKV, C1 = C0 + 4 * N_SQ, C2 = C1 + 4 * N_SQ, C3 = C2 + 64 * N_EXP, C4 = C3 + 64 * N_EXP, C5 = C4 + 4 * N_W2,
              C6 = C5 + 2 * N_EVIN, C7 = C6 + 2 * N_SQ, C8 = C7 + 2 * N_GLU, C9 = C8 + 2 * N_ODIN;
constexpr int NL_COMMON = 2 * N_SQ + 32 * N_EXP + N_W2;
__device__ __forceinline__ int layer_items(int L) { return NL_COMMON + ((L & 1) ? (N_ODIN + N_SQ) : (N_EVIN + N_SQ + N_GLU)); }
__device__ __forceinline__ int layer_item(int L, int k) {
    if (k < 0) return k + N_MKV;
    const int j = L >> 1;
    if (k < N_SQ) return C0 + L * N_SQ + k; k -= N_SQ;
    if (k < N_SQ) return C1 + L * N_SQ + k; k -= N_SQ;
    if (k < 16 * N_EXP) return C2 + L * 16 * N_EXP + k; k -= 16 * N_EXP;
    if (k < 16 * N_EXP) return C3 + L * 16 * N_EXP + k; k -= 16 * N_EXP;
    if (k < N_W2) return C4 + L * N_W2 + k; k -= N_W2;
    if (L & 1) { if (k < N_ODIN) return C8 + j * N_ODIN + k; k -= N_ODIN; return C9 + j * N_SQ + k; }
    if (k < N_EVIN) return C5 + j * N_EVIN + k; k -= N_EVIN;
    if (k < N_SQ) return C6 + j * N_SQ + k; k -= N_SQ;
    return C7 + j * N_GLU + k;
}
}
__device__ __forceinline__ void convert_layer(const Args& a, unsigned char* ws, float* scr, int lane, int L, int klo, int w, int nw, int khi = 1 << 30) {
    const int nl = wc::layer_items(L), n = khi < nl ? khi : nl;
    if (klo + w >= n) return;
    XI cur = xi_decode(a, ws, wc::layer_item(L, klo + w)); float va[32], vb[32]; xi_load(cur, lane, va);
    for (int k = klo + w; k < n; k += 2 * nw) {
        const bool h1 = k + nw < n; XI nx = cur; if (h1) { nx = xi_decode(a, ws, wc::layer_item(L, k + nw)); xi_load(nx, lane, vb); }
        xi_finish(cur, va, scr, lane);
        if (!h1) break;
        const bool h2 = k + 2 * nw < n; if (h2) { cur = xi_decode(a, ws, wc::layer_item(L, k + 2 * nw)); xi_load(cur, lane, va); }
        xi_finish(nx, vb, scr, lane);
        if (!h2) break;
    }
}
__device__ __forceinline__ int conv_share0(int L, int G) { if (G != 256 || L + 1 >= DEPTH) return 0; const int pct = (L == 0) ? 25 : (L == 1) ? 12 : 35; return wc::layer_items(L + 1) * pct / 100; }
constexpr int XI_TOTAL = 16 * 64 + 8 * 16 * 32 + 128 * 16 * 8 + 4 * 64 * 32 + 2 * 16 * 48 + 2 * 16 * 32 + 2 * 8 * 16 + 2 * 16 * 113 + 2 * 16 * 32;

__device__ __forceinline__ void ph_prologue(int WV_, const Args& a, unsigned char* lds) {
    const int tid = otid(), lane = tid & 63, wave = __builtin_amdgcn_readfirstlane(tid >> 6);
    const int G = gridDim.x, gw = blockIdx.x * 8 + wave, NGW = G * 8;
    unsigned char* ws = a.ws;
    float* scr = (float*)(lds + wave * 16384);
    convert_layer(a, ws, scr, lane, 0, -wc::N_MKV, gw, NGW);
    const int gt = blockIdx.x * NTHR + tid, NGT = G * NTHR;
    { bf16_t* gm = (bf16_t*)(ws + WS_GMW);
      for (int i = gt; i < 2 * 4 * 128 * 128; i += NGT) { const int s = i & 127, t = (i >> 7) & 127; gm[i] = (s <= t) ? f2bf(inp(a, I_GMWS)[i]) : (bf16_t)0; } }
    { bf16_t* wrb = (bf16_t*)(ws + WS_WRB);
      for (int i = gt; i < 4 * 32 * 1024; i += NGT) { const int k = i & 1023, o = (i >> 10) & 31, L = i >> 15; float w = 0.f;
          if (o < 20) w = inp(a, I_NFFN)[L * D + k] * ((o < 4) ? inp(a, I_WGRP)[((size_t)L * 1024 + k) * 4 + o] : inp(a, I_WEXP)[((size_t)L * 1024 + k) * 16 + (o - 4)]);
          const bf16_t hi = f2bf(w); wrb[((size_t)(L * 2) * 32 + o) * 1024 + k] = hi; wrb[((size_t)(L * 2 + 1) * 32 + o) * 1024 + k] = f2bf(w - bf2f(hi)); }
      for (int i = gt; i < 2 * 224 * 1024 / 8; i += NGT) { const int j = i / (224 * 128), r = i % (224 * 128);
          *(u32x4*)((bf16_t*)(ws + WS_WODIN) + ((size_t)j * ODD_NP + 3616) * 1024 + (size_t)r * 8) = zero4(); }
    }
    { float* lamb = (float*)(ws + WS_LAMB); float* bbar = (float*)(ws + WS_BBAR);
      for (int i = gt; i < 2 * 32 * 64; i += NGT) { const int jg = i >> 6;
          const float lr = inp(a, I_LAMRE)[i], li = inp(a, I_LAMIM)[i], step = expf(inp(a, I_LOGSTEP)[jg]);
          const float mag = expf(lr * step), ang = li * step; float sn, cs; sn = sinf(ang); cs = cosf(ang);
          const float br = mag * cs, bi = mag * sn;
          lamb[2 * i] = br; lamb[2 * i + 1] = bi;
          const float nr = br - 1.f, ni = bi, den = lr * lr + li * li;
          const float cr = (nr * lr + ni * li) / den, ci = (ni * lr - nr * li) / den;
          for (int k = 0; k < 16; ++k) { const float xr = inp(a, I_BRE)[(size_t)i * 16 + k], xi = inp(a, I_BIM)[(size_t)i * 16 + k];
              bbar[((size_t)i * 16 + k) * 2] = cr * xr - ci * xi; bbar[((size_t)i * 16 + k) * 2 + 1] = cr * xi + ci * xr; } } }
    if (blockIdx.x == 0 && tid < 256) ((int*)(ws + WS_MCNT))[tid] = 0;
    { bf16_t* hb = (bf16_t*)(ws + WS_XN); float* ss0 = (float*)(ws + WS_SS);
      for (int m = gw; m < T; m += NGW) {
          const f32x4* xr = (const f32x4*)(inp(a, I_X) + (size_t)m * D) + lane; u32x2* o8 = (u32x2*)(hb + (size_t)m * D) + lane; float sq = 0.f;
#pragma unroll
          for (int j = 0; j < 4; ++j) { const f32x4 v = xr[64 * j]; sq += (v.x * v.x + v.y * v.y) + (v.z * v.z + v.w * v.w);
              u32x2 o; o.x = pk2(v.x, v.y); o.y = pk2(v.z, v.w); o8[64 * j] = o; }
          sq = wave_sum(sq); if (lane < 16) ss0[(size_t)m * 16 + lane] = (lane == 0) ? sq : 0.f; } }
    { const float* gp = inp(a, I_MEMG); bf16_t* mn = (bf16_t*)(ws + WS_MEMN);
      for (int m = gw; m < BATCH * NMEM; m += NGW) {
          const f32x4* xr = (const f32x4*)(inp(a, I_MEM) + (size_t)m * D) + lane; f32x4 v[4]; float s = 0.f;
#pragma unroll
          for (int j = 0; j < 4; ++j) { v[j] = xr[64 * j]; s += (v[j].x * v[j].x + v[j].y * v[j].y) + (v[j].z * v[j].z + v[j].w * v[j].w); }
          const float rstd = 1.f / sqrtf(wave_sum(s) * (1.f / D) + EPS);
          u32x2* o8 = (u32x2*)(mn + (size_t)m * D) + lane;
#pragma unroll
          for (int j = 0; j < 4; ++j) { const f32x4 gg = ((const f32x4*)gp)[lane + 64 * j];
              u32x2 o; o.x = pk2(v[j].x * rstd * gg.x, v[j].y * rstd * gg.y); o.y = pk2(v[j].z * rstd * gg.z, v[j].w * rstd * gg.w); o8[64 * j] = o; } } }
}

template <int NOUT>
__device__ __forceinline__ void ph_norm(int WV_, const float* h, const float* g, bf16_t* xn, const float* wt, const float* bias_grp, const float* bias_exp, float* outv) {
    const int tid = otid(), lane = tid & 63, wave = __builtin_amdgcn_readfirstlane(tid >> 6);
    const int gw = blockIdx.x * 8 + wave, NGW = gridDim.x * 8;
    f32x4 gg[4];
#pragma unroll
    for (int j = 0; j < 4; ++j) gg[j] = ((const f32x4*)g)[lane + 64 * j];
    for (int m = gw; m < T; m += NGW) {
        const f32x4* xr = (const f32x4*)(h + (size_t)m * D) + lane; f32x4 v[4]; float s = 0.f;
#pragma unroll
        for (int j = 0; j < 4; ++j) { v[j] = xr[64 * j]; s += (v[j].x * v[j].x + v[j].y * v[j].y) + (v[j].z * v[j].z + v[j].w * v[j].w); }
        const float rstd = 1.f / sqrtf(wave_sum(s) * (1.f / D) + EPS);
        u32x2* o8 = (u32x2*)(xn + (size_t)m * D) + lane;
#pragma unroll
        for (int j = 0; j < 4; ++j) { v[j].x *= rstd * gg[j].x; v[j].y *= rstd * gg[j].y; v[j].z *= rstd * gg[j].z; v[j].w *= rstd * gg[j].w;
            u32x2 o; o.x = pk2(v[j].x, v[j].y); o.y = pk2(v[j].z, v[j].w); o8[64 * j] = o; }
        if constexpr (NOUT > 0) {
            float mine = 0.f;
#pragma unroll 1
            for (int o = 0; o < NOUT; ++o) { float p = 0.f;
#pragma unroll
                for (int j = 0; j < 4; ++j) { const f32x4 w = ((const f32x4*)(wt + (size_t)o * D))[lane + 64 * j]; p += (v[j].x * w.x + v[j].y * w.y) + (v[j].z * w.z + v[j].w * w.w); }
                p = wave_sum(p); mine = (lane == o) ? p : mine; }
            if constexpr (NOUT == 8) { if (lane < 8) outv[(size_t)m * 8 + lane] = mine; }
            if constexpr (NOUT == 20) {
                float dots[20];
#pragma unroll
                for (int o = 0; o < 20; ++o) dots[o] = __builtin_bit_cast(float, __builtin_amdgcn_readlane(__builtin_bit_cast(int, mine), o));
                float gl[4];
#pragma unroll
                for (int o = 0; o < 4; ++o) gl[o] = dots[o] + bias_grp[o];
                int grp = 0; float gmax = gl[0];
#pragma unroll
                for (int o = 1; o < 4; ++o) if (gl[o] > gmax) { gmax = gl[o]; grp = o; }
                float gs = 0.f;
#pragma unroll
                for (int o = 0; o < 4; ++o) gs += __expf(gl[o] - gmax);
                const float gp = 1.f / gs;
                float sl[4];
#pragma unroll
                for (int o = 0; o < 4; ++o) { float x = dots[4 + o] + bias_exp[o];
#pragma unroll
                    for (int q = 1; q < 4; ++q) x = (grp == q) ? dots[4 + 4 * q + o] + bias_exp[4 * q + o] : x;
                    sl[o] = x; }
                int i0 = 0; float v0 = sl[0];
#pragma unroll
                for (int o = 1; o < 4; ++o) if (sl[o] > v0) { v0 = sl[o]; i0 = o; }
                int i1 = -1; float v1 = -3.0e38f;
#pragma unroll
                for (int o = 0; o < 4; ++o) if (o != i0 && sl[o] > v1) { v1 = sl[o]; i1 = o; }
                const float e1 = __expf(v1 - v0), w0 = gp / (1.f + e1), w1 = gp * e1 / (1.f + e1);
                if (lane < 16) { const int ge = lane >> 2, le = lane & 3; float w = 0.f; if (ge == grp) w = (le == i0) ? w0 : ((le == i1) ? w1 : 0.f); outv[(size_t)m * 16 + lane] = w; }
            }
        }
    }
}


__device__ __forceinline__ void ph_router(int WV_, unsigned char* lds, const bf16_t* hb, const bf16_t* wrb  , const float* bias_grp, const float* bias_exp, int* cnt, int* idx, float* gs, float* rstd_slot, int chunk0, int cstride) {
    const int tid = otid(), lane = tid & 63, wave = __builtin_amdgcn_readfirstlane(tid >> 6), mt = wave & 3, kh = wave >> 2;
    constexpr int LDW = 2048 + 16;
    unsigned char* wl = lds;
    float* lg = (float*)(lds + 48 * LDW);
    float* sqp = lg + 2 * 64 * 33;
    float* rs_l = sqp + 128;
    for (int chunk = chunk0; chunk < T / 64; chunk += cstride) {
        __syncthreads();
        const bf16_t* arow = hb + (size_t)(chunk * 64 + 16 * mt + (lane & 15)) * D + kh * 512 + 8 * (lane >> 4);
        u32x4 av[16], wv[12];
#pragma unroll
        for (int ks = 0; ks < 16; ++ks) av[ks] = *(const u32x4*)(arow + 32 * ks);
#pragma unroll
        for (int i = 0; i < 12; ++i) { const int p = tid + NTHR * i, r48 = p >> 7; wv[i] = *(const u32x4*)(wrb + (size_t)(r48 + ((r48 >= 24) ? 8 : 0)) * 1024 + (p & 127) * 8); }
#pragma unroll
        for (int i = 0; i < 12; ++i) { const int p = tid + NTHR * i; *(u32x4*)(wl + (p >> 7) * LDW + (p & 127) * 16) = wv[i]; }
        __syncthreads();
        f32x4 acc[2] = {(f32x4){0.f, 0.f, 0.f, 0.f}, (f32x4){0.f, 0.f, 0.f, 0.f}}; float sq = 0.f;
#pragma unroll
        for (int ks = 0; ks < 16; ++ks) { float f[8]; unpack8(av[ks], f);
#pragma unroll
            for (int j = 0; j < 8; ++j) sq += f[j] * f[j];
            const bf16x8 a8 = __builtin_bit_cast(bf16x8, av[ks]);
#pragma unroll
            for (int nt = 0; nt < 2; ++nt) { const int wr_ = (16 * nt + (lane & 15)) < 23 ? (16 * nt + (lane & 15)) : 23; const unsigned char* wp = wl + wr_ * LDW + (kh * 512 + 32 * ks + 8 * (lane >> 4)) * 2;
                acc[nt] = MFMA16(a8, *(const bf16x8*)wp, acc[nt]); acc[nt] = MFMA16(a8, *(const bf16x8*)(wp + 24 * LDW), acc[nt]); } }
        sq = sum_rows(sq);
        if (lane < 16) sqp[kh * 64 + 16 * mt + lane] = sq;
#pragma unroll
        for (int nt = 0; nt < 2; ++nt)
#pragma unroll
            for (int r = 0; r < 4; ++r) lg[(kh * 64 + 16 * mt + 4 * (lane >> 4) + r) * 33 + 16 * nt + (lane & 15)] = acc[nt][r];
        __syncthreads();
        if (wave == 0) { rs_l[lane] = 1.f / sqrtf((sqp[lane] + sqp[64 + lane]) * (1.f / D) + EPS);
#pragma unroll
            for (int o = 0; o < 20; ++o) lg[lane * 33 + o] += lg[(64 + lane) * 33 + o]; }
        if (wave == 0) {
            const float rstd = rs_l[lane]; float dots[20];
#pragma unroll
            for (int o = 0; o < 20; ++o) dots[o] = lg[lane * 33 + o] * rstd;
            float gl[4];
#pragma unroll
            for (int o = 0; o < 4; ++o) gl[o] = dots[o] + bias_grp[o];
            int grp = 0; float gmax = gl[0];
#pragma unroll
            for (int o = 1; o < 4; ++o) if (gl[o] > gmax) { gmax = gl[o]; grp = o; }
            float gsum = 0.f;
#pragma unroll
            for (int o = 0; o < 4; ++o) gsum += __expf(gl[o] - gmax);
            const float gp = 1.f / gsum;
            float sl[4];
#pragma unroll
            for (int o = 0; o < 4; ++o) { float x = dots[4 + o] + bias_exp[o];
#pragma unroll
                for (int q = 1; q < 4; ++q) x = (grp == q) ? dots[4 + 4 * q + o] + bias_exp[4 * q + o] : x;
                sl[o] = x; }
            int i0 = 0; float v0 = sl[0];
#pragma unroll
            for (int o = 1; o < 4; ++o) if (sl[o] > v0) { v0 = sl[o]; i0 = o; }
            int i1 = -1; float v1 = -3.0e38f;
#pragma unroll
            for (int o = 0; o < 4; ++o) if (o != i0 && sl[o] > v1) { v1 = sl[o]; i1 = o; }
            const float e1 = __expf(v1 - v0), w0 = gp / (1.f + e1), w1 = gp * e1 / (1.f + e1);
            const int ilo = (i0 < i1) ? i0 : i1, ihi = (i0 < i1) ? i1 : i0; const float wlo = (i0 < i1) ? w0 : w1, whi = (i0 < i1) ? w1 : w0;
            const int gq = grp * 6 + ((ilo * (7 - ilo)) >> 1) + (ihi - ilo - 1);
            int mycnt = 0, rank = 0;
#pragma unroll 4
            for (int bq = 0; bq < 24; ++bq) { const unsigned long long mb = __ballot(gq == bq); if (lane == bq) mycnt = (int)__popcll(mb); if (gq == bq) rank = (int)__popcll(mb & ((1ull << lane) - 1ull)); }
            int basev = 0;
            if (lane < 24 && mycnt > 0) basev = atomicAdd(&cnt[lane], mycnt);
            const int mybase = __builtin_bit_cast(int, __builtin_amdgcn_ds_bpermute(gq << 2, basev));
            const size_t pos = (size_t)gq * T + mybase + rank; idx[pos] = chunk * 64 + lane; *(f32x2*)(gs + pos * 2) = (f32x2){wlo, whi}; rstd_slot[pos] = rstd; }
    }
}
struct BselUp { const bf16_t* base; __device__ __forceinline__ const char* operator()(const pg8::GUnit& u) const { return (const char*)(base + (size_t)((u.g >> 1) * 4096 + (u.g & 1) * 2048 + u.pn * 256) * 1024); } };
struct BselMoe { const bf16_t* up; const bf16_t* dn; __device__ __forceinline__ const char* operator()(const pg8::MUnit& u) const {
    return u.kind ? (const char*)(dn + ((size_t)u.g * 1024 + u.pn * 256) * 1024) : (const char*)(up + (size_t)((u.g >> 1) * 4096 + (u.g & 1) * 2048 + u.pn * 256) * 1024); } };
struct BselMoe2 { const bf16_t* up; const bf16_t* dn; __device__ __forceinline__ const char* operator()(const pg8::MUnit2& u) const {
    const int e = u.elo() + (u.pn >> 1) * (u.ehi() - u.elo());
    return u.kind ? (const char*)(dn + ((size_t)u.g() * 1024 + u.pn * 256) * 1024 + u.elo() * 256) : (const char*)(up + (size_t)(((u.g() * 4 + e) * 2 + (u.pn & 1)) * 256) * 1024); } };

__device__ __forceinline__ void ph_s5(int WV_, unsigned char* lds, const bf16_t* zs, bf16_t* ys, const float* lamb, const float* bbar, const float* cre, const float* cim, const float* dskip) {
    const int tid = otid(), lane = tid & 63, wave = WV_;
    constexpr int LDU = 80, LDX = 272;
    unsigned char* BtB = lds;
    unsigned char* CtB = BtB + 128 * LDU;
    unsigned char* Ub = CtB + 16 * LDX;
    float* BUf = (float*)(Ub + 3 * 64 * LDU);
    unsigned char* Xb = (unsigned char*)(BUf + 2 * 64 * 128);
    float* XE = (float*)(Xb + 2 * 64 * LDX);
    for (int item = blockIdx.x; item < BATCH * 32; item += gridDim.x) {
        const int b = item >> 5, g = item & 31;
        __syncthreads();
        for (int i = tid; i < 128 * 32; i += NTHR) { const int n = i >> 5, k = i & 31; float v = 0.f;
            if (k < 16) v = bbar[((size_t)(g * 64 + (n >> 1)) * 16 + k) * 2 + (n & 1)];
            *(bf16_t*)(BtB + n * LDU + k * 2) = f2bf(v); }
        for (int i = tid; i < 16 * 128; i += NTHR) { const int n = i >> 7, k = i & 127;
            const float v = (k & 1) ? -cim[(size_t)(g * 16 + n) * 64 + (k >> 1)] : cre[(size_t)(g * 16 + n) * 64 + (k >> 1)];
            *(bf16_t*)(CtB + n * LDX + k * 2) = f2bf(v); }
        for (int i = tid; i < 3 * 64; i += NTHR) { const u32x4 z4 = zero4(); *(u32x4*)(Ub + i * LDU + 32) = z4; *(u32x4*)(Ub + i * LDU + 48) = z4; }
        float lr = 0.f, li = 0.f; f32x2 pw[16]; f32x2 l32 = {0.f, 0.f}, l48 = {0.f, 0.f}, l64 = {0.f, 0.f}; f32x2 xin = {0.f, 0.f};
#pragma unroll
        for (int j = 0; j < 16; ++j) pw[j] = (f32x2){0.f, 0.f};
        if (wave < 4) { lr = lamb[(g * 64 + lane) * 2]; li = lamb[(g * 64 + lane) * 2 + 1]; pw[0] = (f32x2){lr, li};
#pragma unroll
            for (int j = 1; j < 16; ++j) pw[j] = (f32x2){pw[j - 1].x * lr - pw[j - 1].y * li, pw[j - 1].x * li + pw[j - 1].y * lr};
            l32 = (f32x2){pw[15].x * pw[15].x - pw[15].y * pw[15].y, 2.f * pw[15].x * pw[15].y};
            l48 = (f32x2){l32.x * pw[15].x - l32.y * pw[15].y, l32.x * pw[15].y + l32.y * pw[15].x};
            l64 = (f32x2){l32.x * l32.x - l32.y * l32.y, 2.f * l32.x * l32.y}; }
        const float dsk = dskip[g * 16 + (lane & 15)];
        const int ul = tid - 256, ut = (ul >> 2) & 63, uq = ul & 3;
        const bf16_t* usrc = zs + ((size_t)b * SEQ + ut) * MIX + g * 16 + 4 * uq;
        u32x2 ureg = (u32x2){0u, 0u};
        if (wave >= 4) ureg = *(const u32x2*)usrc;
        f32x2 xl[16];
#pragma unroll
        for (int j = 0; j < 16; ++j) xl[j] = (f32x2){0.f, 0.f};
        for (int c = -1; c <= SEQ / 64; ++c) {
            if (wave >= 4) {
                if (c + 1 < SEQ / 64) *(u32x2*)(Ub + ((c + 1) % 3) * 64 * LDU + ut * LDU + uq * 8) = ureg;
                if (wave <= 5 && c >= 1) { const int cc = c - 1; const unsigned char* xa = Xb + (cc & 1) * 64 * LDX; const unsigned char* ub = Ub + (cc % 3) * 64 * LDU;
                    f32x4 acc[2] = {(f32x4){0.f, 0.f, 0.f, 0.f}, (f32x4){0.f, 0.f, 0.f, 0.f}};
#pragma unroll
                    for (int ks = 0; ks < 4; ++ks) { const bf16x8 bf = frag_row((const LAS unsigned char*)CtB, LDX, 0, 32 * ks, lane);
#pragma unroll
                        for (int mi = 0; mi < 2; ++mi) acc[mi] = MFMA16(frag_row((const LAS unsigned char*)xa, LDX, 16 * (2 * (wave - 4) + mi), 32 * ks, lane), bf, acc[mi]); }
#pragma unroll
                    for (int mi = 0; mi < 2; ++mi)
#pragma unroll
                        for (int r = 0; r < 4; ++r) { const int t = 16 * (2 * (wave - 4) + mi) + 4 * (lane >> 4) + r;
                            const float u = bf2f(*(const bf16_t*)(ub + t * LDU + (lane & 15) * 2));
                            ys[((size_t)b * SEQ + cc * 64 + t) * MIX + g * 16 + (lane & 15)] = f2bf(gelu_tanh(acc[mi][r] + dsk * u)); } }
            } else if (c >= 0 && c < SEQ / 64) {
                const float* bu = BUf + (c & 1) * 64 * 128 + (16 * wave) * 128 + 2 * lane; f32x2 bb[16];
#pragma unroll
                for (int j = 0; j < 16; ++j) bb[j] = *(const f32x2*)(bu + j * 128);
                float xr = 0.f, xi = 0.f;
#pragma unroll
                for (int j = 0; j < 16; ++j) { const float nr = lr * xr - li * xi + bb[j].x, ni = lr * xi + li * xr + bb[j].y; xr = nr; xi = ni; xl[j] = (f32x2){xr, xi}; }
                *(f32x2*)(XE + (wave * 64 + lane) * 2) = (f32x2){xr, xi};
            }
            __syncthreads();
            if (wave >= 4) { if (c + 1 < SEQ / 64) { const int cc = c + 1; const unsigned char* ua = Ub + (cc % 3) * 64 * LDU; float* bo = BUf + (cc & 1) * 64 * 128;
                bf16x8 af[4];
#pragma unroll
                for (int mt = 0; mt < 4; ++mt) af[mt] = frag_row((const LAS unsigned char*)ua, LDU, 16 * mt, 0, lane);
#pragma unroll
                for (int nn = 0; nn < 2; ++nn) { const int nt = 2 * (wave - 4) + nn; const bf16x8 bf = frag_row((const LAS unsigned char*)BtB, LDU, 16 * nt, 0, lane);
#pragma unroll
                    for (int mt = 0; mt < 4; ++mt) { f32x4 a4 = MFMA16(af[mt], bf, ((f32x4){0.f, 0.f, 0.f, 0.f}));
#pragma unroll
                        for (int r = 0; r < 4; ++r) bo[(16 * mt + 4 * (lane >> 4) + r) * 128 + 16 * nt + (lane & 15)] = a4[r]; } }
                if (c + 2 < SEQ / 64) ureg = *(const u32x2*)(usrc + (size_t)(c + 2) * 64 * MIX); } }
            else if (c >= 0 && c < SEQ / 64) {
                const f32x2 e0 = *(const f32x2*)(XE + (0 * 64 + lane) * 2), e1 = *(const f32x2*)(XE + (1 * 64 + lane) * 2), e2 = *(const f32x2*)(XE + (2 * 64 + lane) * 2), e3 = *(const f32x2*)(XE + (3 * 64 + lane) * 2);
#define CMUL(a_, b_) ((f32x2){(a_).x * (b_).x - (a_).y * (b_).y, (a_).x * (b_).y + (a_).y * (b_).x})
                const f32x2 l16 = pw[15];
                const f32x2 b0 = xin; f32x2 t1 = CMUL(l16, b0); const f32x2 b1 = (f32x2){t1.x + e0.x, t1.y + e0.y};
                f32x2 t2 = CMUL(l16, b1); const f32x2 b2 = (f32x2){t2.x + e1.x, t2.y + e1.y};
                f32x2 t3 = CMUL(l16, b2); const f32x2 b3 = (f32x2){t3.x + e2.x, t3.y + e2.y};
                f32x2 t4 = CMUL(l16, b3); xin = (f32x2){t4.x + e3.x, t4.y + e3.y};
                const f32x2 xb = (wave == 0) ? b0 : (wave == 1) ? b1 : (wave == 2) ? b2 : b3;
                unsigned char* xo = Xb + (c & 1) * 64 * LDX + (16 * wave) * LDX + lane * 4;
#pragma unroll
                for (int j = 0; j < 16; ++j) { const f32x2 fx = CMUL(pw[j], xb); *(unsigned*)(xo + j * LDX) = pk2(xl[j].x + fx.x, xl[j].y + fx.y); }
#undef CMUL
                (void)l32; (void)l48; (void)l64;
            }
            __syncthreads();
        }
    }
}

constexpr int LD128 = 272;
constexpr int TILE128 = 128 * LD128;
__device__ __forceinline__ void ph_gmlp(int WV_, unsigned char* lds, const bf16_t* zuv, bf16_t* cat, const bf16_t* gmw, const float* gbs, const float* lng, int wg, int nwg, int ilim = 1 << 30) {
    const int tid = otid(), lane = tid & 63, wave = __builtin_amdgcn_readfirstlane(tid >> 6), wm = wave >> 1, wn = wave & 1;
    unsigned char* Wl = lds; unsigned char* Vl = lds + TILE128;
    int hst = -1;
    for (int item = wg; item < BATCH * 16 * 4 && item < ilim; item += nwg) {
        const int h = item & 3, bc = item >> 2; const size_t tok0 = (size_t)bc * 128;
        __syncthreads();
        if (h != hst) { stage_tile(Wl, LD128, gmw + (size_t)h * 128 * 128, 128, 128, 128, tid); hst = h; }
        { const int s = tid >> 2, q = tid & 3; const bf16_t* src = zuv + (tok0 + s) * 1024 + 512 + h * 128 + q * 32;
          float v[32];
#pragma unroll
          for (int c = 0; c < 4; ++c) { float f[8]; unpack8(*(const u32x4*)(src + 8 * c), f);
#pragma unroll
              for (int j = 0; j < 8; ++j) v[8 * c + j] = f[j]; }
          float sm = 0.f;
#pragma unroll
          for (int j = 0; j < 32; ++j) sm += v[j];
          sm = sum4(sm);
          const float mean = sm * (1.f / 128.f); float sq = 0.f;
#pragma unroll
          for (int j = 0; j < 32; ++j) { v[j] -= mean; sq += v[j] * v[j]; }
          sq = sum4(sq);
          const float rstd = 1.f / sqrtf(sq * (1.f / 128.f) + EPS);
#pragma unroll
          for (int c = 0; c < 4; ++c) { float f[8];
#pragma unroll
              for (int j = 0; j < 8; ++j) f[j] = v[8 * c + j] * rstd * lng[h * 128 + q * 32 + 8 * c + j];
              *(u32x4*)(Vl + s * LD128 + (q * 32 + 8 * c) * 2) = pack8(f); } }
        __syncthreads();
        f32x4 acc[2][4];
#pragma unroll
        for (int mi = 0; mi < 2; ++mi)
#pragma unroll
            for (int ni = 0; ni < 4; ++ni) acc[mi][ni] = (f32x4){0.f, 0.f, 0.f, 0.f};
        for (int ks = 0; ks <= wm; ++ks) {
            bf16x8 af[2], bfr[4];
#pragma unroll
            for (int mi = 0; mi < 2; ++mi) af[mi] = frag_row((const LAS unsigned char*)Wl, LD128, 32 * wm + 16 * mi, 32 * ks, lane);
#pragma unroll
            for (int ni = 0; ni < 4; ++ni) bfr[ni] = frag_tr((const LAS unsigned char*)Vl, LD128, 32 * ks, 64 * wn + 16 * ni, lane);
#pragma unroll
            for (int mi = 0; mi < 2; ++mi)
#pragma unroll
                for (int ni = 0; ni < 4; ++ni) acc[mi][ni] = MFMA16(af[mi], bfr[ni], acc[mi][ni]);
        }
        float uv[2][4][4], bsv[2][4];
#pragma unroll
        for (int mi = 0; mi < 2; ++mi)
#pragma unroll
            for (int r = 0; r < 4; ++r) { const int t = 32 * wm + 16 * mi + 4 * (lane >> 4) + r; bsv[mi][r] = gbs[h * 128 + t];
#pragma unroll
                for (int ni = 0; ni < 4; ++ni) uv[mi][r][ni] = bf2f(zuv[(tok0 + t) * 1024 + h * 128 + 64 * wn + 16 * ni + (lane & 15)]); }
        __builtin_amdgcn_sched_barrier(0);
#pragma unroll
        for (int mi = 0; mi < 2; ++mi)
#pragma unroll
            for (int r = 0; r < 4; ++r) { const int t = 32 * wm + 16 * mi + 4 * (lane >> 4) + r;
#pragma unroll
                for (int ni = 0; ni < 4; ++ni) { const int d = 64 * wn + 16 * ni + (lane & 15);
                    cat[(tok0 + t) * 1024 + h * 128 + d] = f2bf(uv[mi][r][ni] * (acc[mi][ni][r] + bsv[mi][r])); } }
    }
}

__device__ __forceinline__ float lds_sum128_le(const float* a, int t) {
    float s = 0.f;
#pragma unroll 8
    for (int j4 = 0; j4 < 32; ++j4) { const f32x4 v = ((const f32x4*)a)[j4]; const int j = 4 * j4;
        s += ((j <= t) ? v[0] : 0.f) + ((j + 1 <= t) ? v[1] : 0.f) + ((j + 2 <= t) ? v[2] : 0.f) + ((j + 3 <= t) ? v[3] : 0.f); }
    return s;
}
__device__ __forceinline__ float lds_max128_le(const float* a, int t) {
    float m = -3.0e38f;
#pragma unroll 8
    for (int j4 = 0; j4 < 32; ++j4) { const f32x4 v = ((const f32x4*)a)[j4]; const int j = 4 * j4;
        m = fmaxf(m, fmaxf(fmaxf((j <= t) ? v[0] : -3.0e38f, (j + 1 <= t) ? v[1] : -3.0e38f), fmaxf((j + 2 <= t) ? v[2] : -3.0e38f, (j + 3 <= t) ? v[3] : -3.0e38f))); }
    return m;
}
__device__ __forceinline__ float lds_sum128(const float* a) {
    float s = 0.f;
#pragma unroll 8
    for (int j4 = 0; j4 < 32; ++j4) { const f32x4 v = ((const f32x4*)a)[j4]; s += (v[0] + v[1]) + (v[2] + v[3]); }
    return s;
}
__device__ __forceinline__ float lds_max128(const float* a) {
    float m = -3.0e38f;
#pragma unroll 8
    for (int j4 = 0; j4 < 32; ++j4) { const f32x4 v = ((const f32x4*)a)[j4]; m = fmaxf(m, fmaxf(fmaxf(v[0], v[1]), fmaxf(v[2], v[3]))); }
    return m;
}
__device__ __forceinline__ float lds_dot128(const unsigned char* row, const float* vec) {
    float s = 0.f;
#pragma unroll 4
    for (int c = 0; c < 16; ++c) { float f[8]; unpack8(*(const u32x4*)(row + 16 * c), f); const f32x4 a = ((const f32x4*)vec)[2 * c], b = ((const f32x4*)vec)[2 * c + 1];
        s += (f[0] * a[0] + f[1] * a[1]) + (f[2] * a[2] + f[3] * a[3]) + (f[4] * b[0] + f[5] * b[1]) + (f[6] * b[2] + f[7] * b[3]); }
    return s;
}
__device__ __forceinline__ void conv_silu32(const bf16_t* zrow  , int pos, const float* cw  , const float* cb, float scale, float (&out)[32]) {
#pragma unroll
    for (int c = 0; c < 4; ++c)
#pragma unroll
        for (int j = 0; j < 8; ++j) out[8 * c + j] = cb[8 * c + j];
#pragma unroll
    for (int tp = 0; tp < 2; ++tp) {
        u32x4 raw[2][4];
#pragma unroll
        for (int t2 = 0; t2 < 2; ++t2) { const int tap = 2 * tp + t2; const bf16_t* src = (pos - 3 + tap >= 0) ? zrow - (size_t)(3 - tap) * ODD_N : zrow;
#pragma unroll
            for (int c = 0; c < 4; ++c) raw[t2][c] = *(const u32x4*)(src + 8 * c); }
#pragma unroll
        for (int t2 = 0; t2 < 2; ++t2) { const int tap = 2 * tp + t2; const float tv = (pos - 3 + tap >= 0) ? 1.f : 0.f;
#pragma unroll
            for (int c = 0; c < 4; ++c) { float f[8]; unpack8(raw[t2][c], f);
#pragma unroll
                for (int j = 0; j < 8; ++j) out[8 * c + j] += (tv * cw[tap * 1024 + 8 * c + j]) * f[j]; } }
        __builtin_amdgcn_sched_barrier(0);
    }
#pragma unroll
    for (int j = 0; j < 32; ++j) out[j] = siluf_(out[j]) * scale;
    __builtin_amdgcn_sched_barrier(0);
}

__device__ __forceinline__ void conv_stage_weights(float* cwl, const float* convw, const float* convb, int h, int p0, int nparts, int tid) {
    for (int i = tid; i < nparts * 640; i += NTHR) { const int isb = i >= nparts * 512; const int r = isb ? i - nparts * 512 : i;
        const int p = isb ? r >> 7 : r >> 9, tap = (r >> 7) & 3, ch = r & 127;
        cwl[i] = isb ? convb[512 * (p0 + p) + h * 128 + ch] : convw[tap * 1024 + 512 * (p0 + p) + h * 128 + ch]; }
}
__device__ __forceinline__ void conv_load(const bf16_t* zrow  , int pos, u32x4 (&raw)[4][4]) {
#pragma unroll
    for (int tap = 0; tap < 4; ++tap) { const bf16_t* src = (pos - 3 + tap >= 0) ? zrow - (size_t)(3 - tap) * ODD_N : zrow;
#pragma unroll
        for (int c = 0; c < 4; ++c) raw[tap][c] = *(const u32x4*)(src + 8 * c); }
}
template <int TS = 1024>
__device__ __forceinline__ void conv_finish(const u32x4 (&raw)[4][4], int pos, const float* cw  , const float* cb, float scale, unsigned char* dst  ) {
#pragma unroll
    for (int c = 0; c < 4; ++c) { float o[8];
#pragma unroll
        for (int j = 0; j < 8; ++j) o[j] = cb[8 * c + j];
#pragma unroll
        for (int tap = 0; tap < 4; ++tap) { const float tv = (pos - 3 + tap >= 0) ? 1.f : 0.f; float f[8]; unpack8(raw[tap][c], f);
#pragma unroll
            for (int j = 0; j < 8; ++j) o[j] += (tv * cw[tap * TS + 8 * c + j]) * f[j]; }
#pragma unroll
        for (int j = 0; j < 8; ++j) o[j] = siluf_(o[j]) * scale;
        *(u32x4*)(dst + 16 * c) = pack8(o);
        __builtin_amdgcn_sched_barrier(0); }
}

__device__ __forceinline__ void ph_mlstm1(int WV_, unsigned char* lds, const bf16_t* z, const float* gates, const float* bif, const float* convw, const float* convb,
                                          bf16_t* kv, float* nloc, float* mloc, float* gsum) {
    const int tid = otid(), lane = tid & 63, wave = __builtin_amdgcn_readfirstlane(tid >> 6), wm = wave >> 1, wn = wave & 1;
    unsigned char* Kl = lds; unsigned char* Vl = lds + TILE128; float* fa = (float*)(lds + 2 * TILE128);
    float* cwl = fa + 1024;
    int hst = -1;
    for (int item = blockIdx.x; item < 512; item += gridDim.x) {
        const int c = item & 15, h = (item >> 4) & 3, b = item >> 6; const size_t tok0 = (size_t)b * SEQ + c * 128;
        __syncthreads();
        if (h != hst) { conv_stage_weights(cwl, convw, convb, h, 1, 1, tid); hst = h; }
        const int l = tid >> 2, q = tid & 3;
        u32x4 rk[4][4], rv[4];
        conv_load(z + (tok0 + l) * ODD_N + 512 + h * 128 + q * 32, c * 128 + l, rk);
#pragma unroll
        for (int jj = 0; jj < 4; ++jj) { const int i = tid + NTHR * jj; rv[jj] = *(const u32x4*)(z + (tok0 + (i >> 4)) * ODD_N + 1024 + h * 128 + (i & 15) * 8); }
        float ml = 0.f, gtot = 0.f;
        if (wave == 0) {
            const float* gp = gates + (tok0 + 2 * lane) * 8; const float bf_ = bif[4 + h], bi_ = bif[h];
            const float f0 = gp[4 + h], f1 = gp[12 + h], i0 = gp[h], i1 = gp[8 + h];
            const float lf0 = logsigmoidf_(f0 + bf_), lf1 = logsigmoidf_(f1 + bf_);
            const float S = wave_scan_add(lf0 + lf1);
            gtot = __builtin_bit_cast(float, __builtin_amdgcn_readlane(__builtin_bit_cast(int, S), 63));
            const float a0 = (gtot - (S - lf1)) + i0 + bi_, a1 = (gtot - S) + i1 + bi_;
            float mx = max16(fmaxf(a0, a1)); mx = fmaxf(mx, xor16f(mx)); ml = max_x32(mx);
            *(f32x2*)(fa + 256 + 2 * lane) = (f32x2){fexp(a0 - ml), fexp(a1 - ml)};
        }
        __syncthreads();
        conv_finish<128>(rk, c * 128 + l, cwl + q * 32, cwl + 512 + q * 32, 0.08838834764831845f * fa[256 + l], Kl + l * LD128 + q * 64);
#pragma unroll
        for (int jj = 0; jj < 4; ++jj) { const int i = tid + NTHR * jj; *(u32x4*)(Vl + (i >> 4) * LD128 + (i & 15) * 16) = rv[jj]; }
        __syncthreads();
        f32x4 acc[2][4], nacc[4];
        const bf16x8 ones = __builtin_bit_cast(bf16x8, (u32x4){0x3F803F80u, 0x3F803F80u, 0x3F803F80u, 0x3F803F80u});
#pragma unroll
        for (int mi = 0; mi < 2; ++mi)
#pragma unroll
            for (int ni = 0; ni < 4; ++ni) { acc[mi][ni] = (f32x4){0.f, 0.f, 0.f, 0.f}; nacc[ni] = (f32x4){0.f, 0.f, 0.f, 0.f}; }
#pragma unroll
        for (int ks = 0; ks < 4; ++ks) {
            bf16x8 af[2], bfr[4];
#pragma unroll
            for (int mi = 0; mi < 2; ++mi) af[mi] = frag_tr((const LAS unsigned char*)Vl, LD128, 32 * ks, 32 * wm + 16 * mi, lane);
#pragma unroll
            for (int ni = 0; ni < 4; ++ni) bfr[ni] = frag_tr((const LAS unsigned char*)Kl, LD128, 32 * ks, 64 * wn + 16 * ni, lane);
#pragma unroll
            for (int mi = 0; mi < 2; ++mi)
#pragma unroll
                for (int ni = 0; ni < 4; ++ni) acc[mi][ni] = MFMA16(af[mi], bfr[ni], acc[mi][ni]);
            if (wm == 0) {
#pragma unroll
                for (int ni = 0; ni < 4; ++ni) nacc[ni] = MFMA16(ones, bfr[ni], nacc[ni]); }
        }
        bf16_t* kvt = kv + (size_t)item * 16384;
#pragma unroll
        for (int mi = 0; mi < 2; ++mi)
#pragma unroll
            for (int r = 0; r < 4; ++r) { const int e = 32 * wm + 16 * mi + 4 * (lane >> 4) + r;
#pragma unroll
                for (int ni = 0; ni < 4; ++ni) kvt[e * 128 + 64 * wn + 16 * ni + (lane & 15)] = f2bf(acc[mi][ni][r]); }
        if (wm == 0 && lane < 16) {
#pragma unroll
            for (int ni = 0; ni < 4; ++ni) nloc[(size_t)item * 128 + 64 * wn + 16 * ni + lane] = nacc[ni][0]; }
        if (tid == 0) { mloc[item] = ml; gsum[item] = gtot; }
    }
}
__device__ __forceinline__ void ph_mlstm2(int WV_, bf16_t* kv, float* nloc, const float* mloc, const float* gsum, float* ms) {
    const int tid = otid();
    float xn[16];
#define M2_LOAD(it_, dst) { const int bh_ = (it_) / 33, blk_ = (it_) % 33; \
        if (blk_ == 32) { _Pragma("unroll") for (int c = 0; c < 16; ++c) dst[c] = (tid < 128) ? nloc[(size_t)bh_ * 16 * 128 + tid + c * 128] : 0.f; } \
        else { const bf16_t* base_ = kv + (size_t)bh_ * 16 * 16384 + blk_ * NTHR + tid; _Pragma("unroll") for (int c = 0; c < 16; ++c) dst[c] = bf2f(base_[(size_t)c * 16384]); } }
    int item = blockIdx.x;
    if (item < 32 * 33) M2_LOAD(item, xn)
    for (; item < 32 * 33; item += gridDim.x) {
        const int bh = item / 33, blk = item % 33;
        float dec[16], sc[16], x[16]; float m = 0.f;
#pragma unroll
        for (int c = 0; c < 16; ++c) x[c] = xn[c];
#pragma unroll
        for (int c = 0; c < 16; ++c) { const float G = gsum[bh * 16 + c], ML = mloc[bh * 16 + c]; const float mn = fmaxf(G + m, ML); dec[c] = fexp(G + m - mn); sc[c] = fexp(ML - mn);
            if (blk == 32 && tid == 0) ms[bh * 16 + c] = m;
            m = mn; }
        const int nitem = item + gridDim.x;
        if (nitem < 32 * 33) M2_LOAD(nitem, xn)
        if (blk == 32) {
            if (tid < 128) { float* base = nloc + (size_t)bh * 16 * 128 + tid;
                float C = 0.f;
#pragma unroll
                for (int c = 0; c < 16; ++c) { base[c * 128] = C; C = dec[c] * C + sc[c] * x[c]; } }
        } else {
            bf16_t* base = kv + (size_t)bh * 16 * 16384 + blk * NTHR + tid;
            float C = 0.f;
#pragma unroll
            for (int c = 0; c < 16; ++c) { base[(size_t)c * 16384] = f2bf(C); C = dec[c] * C + sc[c] * x[c]; }
        }
    }
#undef M2_LOAD
}
__device__ __forceinline__ void ph_mlstm3(int WV_, unsigned char* lds, const bf16_t* z, const float* gates, const float* bif, const float* convw, const float* convb,
                                          const bf16_t* kv, const float* nst, const float* ms, const float* hng, bf16_t* cat) {
    const int tid = otid(), lane = tid & 63, wave = __builtin_amdgcn_readfirstlane(tid >> 6), wm = wave >> 1, wn = wave & 1;
    unsigned char* Ql = lds; unsigned char* Kl = lds + TILE128; unsigned char* Cl = lds + 2 * TILE128; unsigned char* Vl = lds + 3 * TILE128;
    float* fa = (float*)(lds + 4 * TILE128);
    float* bcum = fa; float* uu = fa + 128; float* mt = fa + 256; float* iw = fa + 384; float* rowsum = fa + 512; float* rowss = fa + 640; float* nsv = fa + 768; float* qn = fa + 896; float* cf = fa + 1024; float* rf = fa + 1152;
    float* cwl = fa + 1280;
    int hst = -1;
    for (int item = blockIdx.x; item < 512; item += gridDim.x) {
        const int c = item & 15, h = (item >> 4) & 3, b = item >> 6; const size_t tok0 = (size_t)b * SEQ + c * 128;
        const float msv = ms[item];
        __syncthreads();
        if (h != hst) { conv_stage_weights(cwl, convw, convb, h, 0, 2, tid); hst = h; __syncthreads(); }
        float gf0 = 0.f, gf1 = 0.f, gi0 = 0.f, gi1 = 0.f; f32x2 ns2 = (f32x2){0.f, 0.f};
        if (wave == 0) { const float* gp = gates + (tok0 + 2 * lane) * 8; gf0 = gp[4 + h]; gf1 = gp[12 + h]; gi0 = gp[h]; gi1 = gp[8 + h]; ns2 = *(const f32x2*)(nst + (size_t)item * 128 + 2 * lane); }
        { const int l = tid >> 2, q = tid & 3; u32x4 rq[4][4];
          conv_load(z + (tok0 + l) * ODD_N + h * 128 + q * 32, c * 128 + l, rq);
          conv_finish<128>(rq, c * 128 + l, cwl + q * 32, cwl + 1024 + q * 32, 1.f, Ql + l * LD128 + q * 64);
          __builtin_amdgcn_sched_barrier(0);
          conv_load(z + (tok0 + l) * ODD_N + 512 + h * 128 + q * 32, c * 128 + l, rq);
          conv_finish<128>(rq, c * 128 + l, cwl + 512 + q * 32, cwl + 1024 + 128 + q * 32, 0.08838834764831845f, Kl + l * LD128 + q * 64);
          __builtin_amdgcn_sched_barrier(0); }
        stage_tile(Cl, LD128, kv + (size_t)item * 16384, 128, 128, 128, tid);
        stage_tile(Vl, LD128, z + tok0 * ODD_N + 1024 + h * 128, ODD_N, 128, 128, tid);
        if (wave == 0) {
            const float bf_ = bif[4 + h], bi_ = bif[h];
            const float lf0 = logsigmoidf_(gf0 + bf_), lf1 = logsigmoidf_(gf1 + bf_);
            const float S = wave_scan_add(lf0 + lf1); const float b0 = S - lf1, b1 = S;
            const float u0 = gi0 + bi_ - b0, u1 = gi1 + bi_ - b1;
            const float M = wave_scan_max(fmaxf(u0, u1)); const float E = wave_shr1(-3.0e38f, M);
            const float m0 = b0 + fmaxf(msv, fmaxf(E, u0)), m1 = b1 + fmaxf(msv, M);
            *(f32x2*)(mt + 2 * lane) = (f32x2){m0, m1}; *(f32x2*)(iw + 2 * lane) = (f32x2){fexp(b0 + msv - m0), fexp(b1 + msv - m1)};
            *(f32x2*)(cf + 2 * lane) = (f32x2){fexp(u0), fexp(u1)}; *(f32x2*)(rf + 2 * lane) = (f32x2){fexp(b0 - m0), fexp(b1 - m1)};
            *(f32x2*)(rowsum + 2 * lane) = (f32x2){0.f, 0.f}; *(f32x2*)(rowss + 2 * lane) = (f32x2){0.f, 0.f}; *(f32x2*)(nsv + 2 * lane) = ns2;
        }
        __syncthreads();
        { const int r_ = tid >> 2, p_ = tid & 3; const unsigned char* row = Ql + r_ * LD128 + p_ * 64; const float* vec = nsv + p_ * 32; float sd = 0.f;
#pragma unroll
          for (int cc = 0; cc < 4; ++cc) { float f[8]; unpack8(*(const u32x4*)(row + 16 * cc), f); const f32x4 a4 = ((const f32x4*)vec)[2 * cc], b4 = ((const f32x4*)vec)[2 * cc + 1];
              sd += (f[0] * a4[0] + f[1] * a4[1]) + (f[2] * a4[2] + f[3] * a4[3]) + (f[4] * b4[0] + f[5] * b4[1]) + (f[6] * b4[2] + f[7] * b4[3]); }
          sd = sum4(sd); if (p_ == 0) qn[r_] = sd; }
        f32x4 sa[2][4];
#pragma unroll
        for (int mi = 0; mi < 2; ++mi)
#pragma unroll
            for (int ni = 0; ni < 4; ++ni) sa[mi][ni] = (f32x4){0.f, 0.f, 0.f, 0.f};
#pragma unroll
        for (int ks = 0; ks < 4; ++ks) {
            bf16x8 af[2], bfr[4];
#pragma unroll
            for (int mi = 0; mi < 2; ++mi) af[mi] = frag_row((const LAS unsigned char*)Ql, LD128, 32 * wm + 16 * mi, 32 * ks, lane);
#pragma unroll
            for (int ni = 0; ni < 4; ++ni) bfr[ni] = frag_row((const LAS unsigned char*)Kl, LD128, 64 * wn + 16 * ni, 32 * ks, lane);
#pragma unroll
            for (int mi = 0; mi < 2; ++mi)
#pragma unroll
                for (int ni = 0; ni < 4; ++ni) sa[mi][ni] = MFMA16(af[mi], bfr[ni], sa[mi][ni]);
        }
        __syncthreads();
#pragma unroll
        for (int mi = 0; mi < 2; ++mi)
#pragma unroll
            for (int r = 0; r < 4; ++r) { const int t = 32 * wm + 16 * mi + 4 * (lane >> 4) + r; const float rt = rf[t]; float rs = 0.f;
                float us[4];
#pragma unroll
                for (int ni = 0; ni < 4; ++ni) us[ni] = cf[64 * wn + 16 * ni + (lane & 15)];
#pragma unroll
                for (int ni = 0; ni < 4; ++ni) { const int s = 64 * wn + 16 * ni + (lane & 15);
                    const float w = (s <= t) ? rt * us[ni] : 0.f; const float v = sa[mi][ni][r] * w; rs += v;
                    *(bf16_t*)(Kl + t * LD128 + s * 2) = f2bf(v); }
                rs = sum16(rs); if ((lane & 15) == 0) atomicAdd(&rowsum[t], rs); }
        __syncthreads();
        f32x4 ao[2][4], ai[2][4];
#pragma unroll
        for (int mi = 0; mi < 2; ++mi)
#pragma unroll
            for (int ni = 0; ni < 4; ++ni) { ao[mi][ni] = (f32x4){0.f, 0.f, 0.f, 0.f}; ai[mi][ni] = (f32x4){0.f, 0.f, 0.f, 0.f}; }
#pragma unroll
        for (int ks = 0; ks < 4; ++ks) {
            bf16x8 af[2], bfr[4];
#pragma unroll
            for (int mi = 0; mi < 2; ++mi) af[mi] = frag_row((const LAS unsigned char*)Kl, LD128, 32 * wm + 16 * mi, 32 * ks, lane);
#pragma unroll
            for (int ni = 0; ni < 4; ++ni) bfr[ni] = frag_tr((const LAS unsigned char*)Vl, LD128, 32 * ks, 64 * wn + 16 * ni, lane);
#pragma unroll
            for (int mi = 0; mi < 2; ++mi)
#pragma unroll
                for (int ni = 0; ni < 4; ++ni) ao[mi][ni] = MFMA16(af[mi], bfr[ni], ao[mi][ni]);
#pragma unroll
            for (int mi = 0; mi < 2; ++mi) af[mi] = frag_row((const LAS unsigned char*)Ql, LD128, 32 * wm + 16 * mi, 32 * ks, lane);
#pragma unroll
            for (int ni = 0; ni < 4; ++ni) bfr[ni] = frag_row((const LAS unsigned char*)Cl, LD128, 64 * wn + 16 * ni, 32 * ks, lane);
#pragma unroll
            for (int mi = 0; mi < 2; ++mi)
#pragma unroll
                for (int ni = 0; ni < 4; ++ni) ai[mi][ni] = MFMA16(af[mi], bfr[ni], ai[mi][ni]);
        }
        float ogv[2][4][4], hgv[4];
#pragma unroll
        for (int ni = 0; ni < 4; ++ni) hgv[ni] = hng[h * 128 + 64 * wn + 16 * ni + (lane & 15)];
#pragma unroll
        for (int mi = 0; mi < 2; ++mi)
#pragma unroll
            for (int r = 0; r < 4; ++r) { const int t = 32 * wm + 16 * mi + 4 * (lane >> 4) + r;
#pragma unroll
                for (int ni = 0; ni < 4; ++ni) ogv[mi][r][ni] = bf2f(z[(tok0 + t) * ODD_N + 1536 + h * 128 + 64 * wn + 16 * ni + (lane & 15)]); }
#pragma unroll
        for (int mi = 0; mi < 2; ++mi)
#pragma unroll
            for (int r = 0; r < 4; ++r) { const int t = 32 * wm + 16 * mi + 4 * (lane >> 4) + r;
                const float w = iw[t], den = w * qn[t] + rowsum[t], dd = fmaxf(fabsf(den), fexp(-mt[t])), inv = 1.f / dd; float ss = 0.f;
#pragma unroll
                for (int ni = 0; ni < 4; ++ni) { const float o = (w * ai[mi][ni][r] + ao[mi][ni][r]) * inv; ao[mi][ni][r] = o; ss += o * o; }
                ss = sum16(ss); if ((lane & 15) == 0) atomicAdd(&rowss[t], ss); }
        __syncthreads();
#pragma unroll
        for (int mi = 0; mi < 2; ++mi)
#pragma unroll
            for (int r = 0; r < 4; ++r) { const int t = 32 * wm + 16 * mi + 4 * (lane >> 4) + r; const float rstd = 1.f / sqrtf(rowss[t] * (1.f / 128.f) + EPS);
#pragma unroll
                for (int ni = 0; ni < 4; ++ni) { const int e = 64 * wn + 16 * ni + (lane & 15);
                    cat[(tok0 + t) * 1024 + h * 128 + e] = f2bf(ao[mi][ni][r] * rstd * hgv[ni] * sigmoidf_(ogv[mi][r][ni])); } }
    }
}

__device__ __forceinline__ void ph_moba_prep(int WV_, unsigned char* lds, bf16_t* z, const float* qg, const float* kg, float* ksum) {
    const int tid = otid(), lane = tid & 63, wave = __builtin_amdgcn_readfirstlane(tid >> 6);
    float* wsum = (float*)lds;
    float* gl = wsum + 8 * 128;
    if (tid < 256) gl[tid] = (tid < 128) ? qg[tid] : kg[tid - 128];
    for (int item = blockIdx.x; item < BATCH * 4 * 8; item += gridDim.x) {
        const int nb = item & 7, h = (item >> 3) & 3, b = item >> 5;
        const int tk = tid >> 1, hf = tid & 1, pos = nb * 256 + tk; const size_t tok = (size_t)b * SEQ + pos;
        bf16_t* qp = z + tok * ODD_N + 2048 + h * 128 + hf * 64; bf16_t* kp = qp + 512;
        float sq = 0.f, sk = 0.f;
#pragma unroll
        for (int c = 0; c < 8; ++c) { float f[8]; unpack8(*(const u32x4*)(qp + 8 * c), f);
#pragma unroll
            for (int j = 0; j < 8; ++j) sq += f[j] * f[j];
            unpack8(*(const u32x4*)(kp + 8 * c), f);
#pragma unroll
            for (int j = 0; j < 8; ++j) sk += f[j] * f[j]; }
        sq += xor1f(sq); sk += xor1f(sk);
        const float rq = (1.f / sqrtf(sq * (1.f / 128.f) + EPS)) * (0.08838834764831845f * LOG2E), rk = 1.f / sqrtf(sk * (1.f / 128.f) + EPS);
        __syncthreads();
        u32x4 nq = *(const u32x4*)qp, nk = *(const u32x4*)kp;
#pragma unroll 1
        for (int c = 0; c < 8; ++c) {
            float fq[8], fk[8]; unpack8(nq, fq); unpack8(nk, fk);
            if (c + 1 < 8) { nq = *(const u32x4*)(qp + 8 * (c + 1)); nk = *(const u32x4*)(kp + 8 * (c + 1)); }
            const f32x4 gq0 = *(const f32x4*)(gl + hf * 64 + 8 * c), gq1 = *(const f32x4*)(gl + hf * 64 + 8 * c + 4), gk0 = *(const f32x4*)(gl + 128 + hf * 64 + 8 * c), gk1 = *(const f32x4*)(gl + 128 + hf * 64 + 8 * c + 4);
            const float gqv[8] = {gq0.x, gq0.y, gq0.z, gq0.w, gq1.x, gq1.y, gq1.z, gq1.w}, gkv[8] = {gk0.x, gk0.y, gk0.z, gk0.w, gk1.x, gk1.y, gk1.z, gk1.w};
            float ks8[8];
#pragma unroll
            for (int jj = 0; jj < 8; ++jj) {
                const int i = 8 * c + jj;
                const float a = fq[jj] * rq * gqv[jj], bq = fk[jj] * rk * gkv[jj];
                const float ao = xor1f(a), bo = xor1f(bq);
                const float invf = fexp2(-(float)i * (13.287712379549449f / 64.f));
                float rev = (float)pos * invf * 0.15915494309189535f; rev -= floorf(rev);
                const float sn = __builtin_amdgcn_sinf(rev), cs = __builtin_amdgcn_cosf(rev);
                fq[jj] = hf ? (ao * sn + a * cs) : (a * cs - ao * sn);
                float kv = hf ? (bo * sn + bq * cs) : (bq * cs - bo * sn);
                fk[jj] = kv;
                kv += xor2f(kv); kv += dppf<0x124>(kv); kv += dppf<0x128>(kv); kv = sum_rows(kv);
                ks8[jj] = kv;
            }
            if (lane < 2) { *(f32x4*)(wsum + wave * 128 + hf * 64 + 8 * c) = (f32x4){ks8[0], ks8[1], ks8[2], ks8[3]}; *(f32x4*)(wsum + wave * 128 + hf * 64 + 8 * c + 4) = (f32x4){ks8[4], ks8[5], ks8[6], ks8[7]}; }
            *(u32x4*)(qp + 8 * c) = pack8(fq);
            *(u32x4*)(kp + 8 * c) = pack8(fk);
        }
        __syncthreads();
        if (tid < 128) { float s = 0.f;
#pragma unroll
            for (int w = 0; w < 8; ++w) s += wsum[w * 128 + tid];
            ksum[(size_t)item * 128 + tid] = s; }
    }
}

template <int DH>
struct AttnState { f32x4 o[DH / 16]; f32x4 lv; };
__device__ __forceinline__ bf16x8 frag_trp(const LAS unsigned char* base, int ld, int k0, int col0, int lane) {
    const int g = lane >> 4, q = (lane & 15) >> 2, p = lane & 3;
    const LAS unsigned char* a = base + (k0 + 4 * g + q) * ld + (col0 + 4 * p) * 2;
    const s16x4 v0 = __builtin_amdgcn_ds_read_tr16_b64_v4i16((LAS s16x4*)a);
    const s16x4 v1 = __builtin_amdgcn_ds_read_tr16_b64_v4i16((LAS s16x4*)(a + 16 * ld));
    return (bf16x8){v0[0], v0[1], v0[2], v0[3], v1[0], v1[1], v1[2], v1[3]};
}
struct MobaMask { bool own, rowsel; int k0, qpos; };
template <int NKT>
__device__ __forceinline__ void moba_p(const f32x4 (&sv)[NKT], const MobaMask& v, int g, bf16x8 (&pf)[NKT / 2]) {
    if (v.own) {
#pragma unroll
        for (int ks = 0; ks < NKT / 2; ++ks) { float p[8];
#pragma unroll
            for (int j = 0; j < 8; ++j) { const int kt = 2 * ks + (j >> 2), r = j & 3; const float e = fexp2(sv[kt][r]); p[j] = (v.k0 + 16 * kt + 4 * g + r <= v.qpos) ? e : 0.f; }
            const u32x4 w = pack8(p); pf[ks] = __builtin_bit_cast(bf16x8, w); }
    } else {
#pragma unroll
        for (int ks = 0; ks < NKT / 2; ++ks) { float p[8];
#pragma unroll
            for (int j = 0; j < 8; ++j) p[j] = fexp2(sv[2 * ks + (j >> 2)][j & 3]);
            u32x4 w = pack8(p); if (!v.rowsel) w = (u32x4){0u, 0u, 0u, 0u};
            pf[ks] = __builtin_bit_cast(bf16x8, w); }
    }
}
template <int DH, int NKT>
__device__ __forceinline__ void moba_S(f32x4 (&sA)[NKT], f32x4 (&sB)[NKT], const bf16x8 (&qaA)[DH / 32], const bf16x8 (&qaB)[DH / 32], bool actA, const unsigned char* Kl, int ldk, int lane) {
#pragma unroll
    for (int kt = 0; kt < NKT; ++kt) { sA[kt] = (f32x4){0.f, 0.f, 0.f, 0.f}; sB[kt] = (f32x4){0.f, 0.f, 0.f, 0.f}; }
    if (actA) {
#pragma unroll
        for (int ks = 0; ks < DH / 32; ++ks) {
#pragma unroll
            for (int kt = 0; kt < NKT; ++kt) { const bf16x8 kf = frag_row((const LAS unsigned char*)Kl, ldk, 16 * kt, 32 * ks, lane); sA[kt] = MFMA16(kf, qaA[ks], sA[kt]); sB[kt] = MFMA16(kf, qaB[ks], sB[kt]); }
            if ((ks & 1) == 1) __builtin_amdgcn_sched_barrier(0); }
    } else {
#pragma unroll
        for (int ks = 0; ks < DH / 32; ++ks) {
#pragma unroll
            for (int kt = 0; kt < NKT; ++kt) sB[kt] = MFMA16(frag_row((const LAS unsigned char*)Kl, ldk, 16 * kt, 32 * ks, lane), qaB[ks], sB[kt]);
            if ((ks & 1) == 1) __builtin_amdgcn_sched_barrier(0); }
    }
}
template <int NKT>
__device__ __forceinline__ void moba_P2(const f32x4 (&sA)[NKT], const f32x4 (&sB)[NKT], bool actA, const MobaMask& validA, const MobaMask& validB, int lane, bf16x8 (&pA)[NKT / 2], bf16x8 (&pB)[NKT / 2]) {
    const int g = lane >> 4;
    moba_p<NKT>(sB, validB, g, pB);
    if (actA) moba_p<NKT>(sA, validA, g, pA);
}
template <int DH, int NKT>
__device__ __forceinline__ void moba_PV(AttnState<DH>& sa_, AttnState<DH>& sb_, const bf16x8 (&pA)[NKT / 2], const bf16x8 (&pB)[NKT / 2], bool actA, const unsigned char* Vl, int ldk, int lane) {
    const bf16x8 ones = __builtin_bit_cast(bf16x8, (u32x4){0x3F803F80u, 0x3F803F80u, 0x3F803F80u, 0x3F803F80u});
    if (actA) {
#pragma unroll
        for (int ks = 0; ks < NKT / 2; ++ks) { sa_.lv = MFMA16(ones, pA[ks], sa_.lv); sb_.lv = MFMA16(ones, pB[ks], sb_.lv); }
#pragma unroll
        for (int ne = 0; ne < DH / 16; ++ne) {
#pragma unroll
            for (int ks = 0; ks < NKT / 2; ++ks) { const bf16x8 vf = frag_trp((const LAS unsigned char*)Vl, ldk, 32 * ks, 16 * ne, lane); sa_.o[ne] = MFMA16(vf, pA[ks], sa_.o[ne]); sb_.o[ne] = MFMA16(vf, pB[ks], sb_.o[ne]); }
            if ((ne & 3) == 3) __builtin_amdgcn_sched_barrier(0); }
    } else {
#pragma unroll
        for (int ks = 0; ks < NKT / 2; ++ks) sb_.lv = MFMA16(ones, pB[ks], sb_.lv);
#pragma unroll
        for (int ne = 0; ne < DH / 16; ++ne) {
#pragma unroll
            for (int ks = 0; ks < NKT / 2; ++ks) sb_.o[ne] = MFMA16(frag_trp((const LAS unsigned char*)Vl, ldk, 32 * ks, 16 * ne, lane), pB[ks], sb_.o[ne]);
            if ((ne & 3) == 3) __builtin_amdgcn_sched_barrier(0); }
    }
}

__device__ __forceinline__ void moba_gate2(int tid, int obA, int obB, const unsigned char* QlA, const unsigned char* QlB, const float* kmean, unsigned* selA, unsigned* selB) {
    const int set = tid >> 8, row = (tid & 255) >> 1, hf = tid & 1; const int ob = set ? obB : obA; const unsigned char* Ql = set ? QlB : QlA; unsigned* sel = set ? selB : selA;
    float gt[7];
#pragma unroll
    for (int n = 0; n < 7; ++n) gt[n] = 0.f;
#pragma unroll 2
    for (int c = 0; c < 8; ++c) { float f[8]; unpack8(*(const u32x4*)(Ql + row * 288 + hf * 128 + 16 * c), f);
#pragma unroll
        for (int n = 0; n < 7; ++n) { const f32x4 a = *(const f32x4*)(kmean + n * 128 + hf * 64 + 8 * c), b2 = *(const f32x4*)(kmean + n * 128 + hf * 64 + 8 * c + 4);
            gt[n] += (f[0] * a[0] + f[1] * a[1]) + (f[2] * a[2] + f[3] * a[3]) + (f[4] * b2[0] + f[5] * b2[1]) + (f[6] * b2[2] + f[7] * b2[3]); } }
#pragma unroll
    for (int n = 0; n < 7; ++n) gt[n] += xor1f(gt[n]);
    if (hf == 0) {
        unsigned mask = 0u;
#pragma unroll
        for (int k = 0; k < 3; ++k) { int bi = -1; float bv = -3.0e38f;
#pragma unroll
            for (int n = 0; n < 7; ++n) if (n < ob && !((mask >> n) & 1u) && gt[n] > bv) { bv = gt[n]; bi = n; }
            if (bi >= 0) mask |= 1u << bi; }
        sel[row] = mask; if (mask) atomicOr(&sel[128], mask);
    }
}
constexpr int LDM = 288;
__device__ __forceinline__ void ph_moba_attn(int WV_, unsigned char* lds, const bf16_t* z, const float* ksum, bf16_t* cat) {
    const int tid = otid(), lane = tid & 63, wave = __builtin_amdgcn_readfirstlane(tid >> 6);
    unsigned char* Ql = lds; unsigned char* Kb = lds + (128 * LDM); unsigned char* Vb = Kb + 2 * 64 * LDM;
    float* kmean = (float*)(Vb + 2 * 64 * LDM);
    unsigned* selA = (unsigned*)(kmean + 8 * 128);
    unsigned* selB = selA + 132;
    for (int item = blockIdx.x; item < 256; item += gridDim.x) {
        const int p = item & 7, h = (item >> 3) & 3, b = item >> 5; const size_t tokb = (size_t)b * SEQ;
        const int qtA = p, qtB = 15 - p, obA = qtA >> 1, obB = qtB >> 1, qA0 = qtA * 128, qB0 = qtB * 128;
        __syncthreads();
        unsigned char* QlB = Kb;
        { u32x4 ra[4], rb[4];
#pragma unroll
          for (int jj = 0; jj < 4; ++jj) { const int i = tid + NTHR * jj; ra[jj] = *(const u32x4*)(z + (tokb + qA0 + (i >> 4)) * ODD_N + 2048 + h * 128 + (i & 15) * 8); rb[jj] = *(const u32x4*)(z + (tokb + qB0 + (i >> 4)) * ODD_N + 2048 + h * 128 + (i & 15) * 8); }
          for (int i = tid; i < 8 * 128; i += NTHR) kmean[i] = ksum[((size_t)(b * 4 + h) * 8) * 128 + i] * (1.f / 256.f);
          if (tid == 0) { selA[128] = 0u; selB[128] = 0u; }
#pragma unroll
          for (int jj = 0; jj < 4; ++jj) { const int i = tid + NTHR * jj; *(u32x4*)(Ql + (i >> 4) * LDM + (i & 15) * 16) = ra[jj]; *(u32x4*)(QlB + (i >> 4) * LDM + (i & 15) * 16) = rb[jj]; } }
        __syncthreads();
        moba_gate2(tid, obA, obB, Ql, QlB, kmean, selA, selB);
        bf16x8 qaA[4], qaB[4];
#pragma unroll
        for (int ks = 0; ks < 4; ++ks) { qaA[ks] = frag_row((const LAS unsigned char*)Ql, LDM, 16 * wave, 32 * ks, lane); qaB[ks] = frag_row((const LAS unsigned char*)QlB, LDM, 16 * wave, 32 * ks, lane); }
        __syncthreads();
        const unsigned anyA = selA[128], anyB = selB[128];
        const unsigned selrA = selA[16 * wave + (lane & 15)], selrB = selB[16 * wave + (lane & 15)];
        AttnState<128> stA, stB;
#pragma unroll
        for (int ne = 0; ne < 8; ++ne) { stA.o[ne] = (f32x4){0.f, 0.f, 0.f, 0.f}; stB.o[ne] = (f32x4){0.f, 0.f, 0.f, 0.f}; }
        stA.lv = (f32x4){0.f, 0.f, 0.f, 0.f}; stB.lv = (f32x4){0.f, 0.f, 0.f, 0.f};
        const int ntA = obA * 4 + (qA0 + 128 - 256 * obA) / 64, ntB = obB * 4 + (qB0 + 128 - 256 * obB) / 64;
#define MB_NEED(t_, ob_, nt_, any_) ((t_) < (nt_) && (((t_) >> 2) == (ob_) || (((any_) >> ((t_) >> 2)) & 1u)))
#define MB_SKIP(t_) while ((t_) < ntB && !MB_NEED(t_, obA, ntA, anyA) && !MB_NEED(t_, obB, ntB, anyB)) (t_) += 1
        const int pr = tid >> 4, pc = tid & 15;
        const bf16_t* kbase = z + tokb * ODD_N + 2560 + h * 128 + pc * 8;
        u32x4 ka0, ka1, va0, va1, kb0, kb1, vb0, vb1;
#define MB_LOAD(t_, k0_, k1_, v0_, v1_) { const bf16_t* p0 = kbase + (size_t)((t_) * 64 + pr) * ODD_N; k0_ = *(const u32x4*)p0; k1_ = *(const u32x4*)(p0 + (size_t)32 * ODD_N); v0_ = *(const u32x4*)(p0 + 512); v1_ = *(const u32x4*)(p0 + (size_t)32 * ODD_N + 512); }
        int ti = 0; MB_SKIP(ti);
        int t1 = ti + 1; MB_SKIP(t1);
        if (ti < ntB) MB_LOAD(ti, ka0, ka1, va0, va1)
        if (t1 < ntB) MB_LOAD(t1, kb0, kb1, vb0, vb1)
        bf16x8 pA[2], pB[2];
#define MB_STEP(k0_, k1_, v0_, v1_, buf_) { \
            const int n = ti >> 2, k0 = ti * 64;                \
            unsigned char* Kl = Kb + (buf_) * 64 * LDM; unsigned char* Vl = Vb + (buf_) * 64 * LDM; \
            *(u32x4*)(Kl + pr * LDM + pc * 16) = k0_; *(u32x4*)(Kl + (pr + 32) * LDM + pc * 16) = k1_; \
            *(u32x4*)(Vl + pr * LDM + pc * 16) = v0_; *(u32x4*)(Vl + (pr + 32) * LDM + pc * 16) = v1_; \
            int t2 = t1 + 1; MB_SKIP(t2); \
            if (t2 < ntB) MB_LOAD(t2, k0_, k1_, v0_, v1_) \
            __syncthreads();                                     \
            const bool actA = MB_NEED(ti, obA, ntA, anyA); \
            const bool ownA = (n == obA), ownB = (n == obB); const int qposA = qA0 + 16 * wave + (lane & 15), qposB = qB0 + 16 * wave + (lane & 15); \
            const bool rsA = ((selrA >> n) & 1u) != 0u, rsB = ((selrB >> n) & 1u) != 0u; \
            f32x4 sA[4], sB[4]; \
            moba_S<128, 4>(sA, sB, qaA, qaB, actA, Kl, LDM, lane); \
            moba_P2<4>(sA, sB, actA, MobaMask{ownA, rsA, k0, qposA}, MobaMask{ownB, rsB, k0, qposB}, lane, pA, pB); \
            moba_PV<128, 4>(stA, stB, pA, pB, actA, Vl, LDM, lane); \
            ti = t1; t1 = t2; }
        while (ti < ntB) {
            MB_STEP(ka0, ka1, va0, va1, 0)
            if (ti >= ntB) break;
            MB_STEP(kb0, kb1, vb0, vb1, 1)
        }
#undef MB_STEP
#undef MB_LOAD
#undef MB_SKIP
#undef MB_NEED
        { const float invA = 1.f / stA.lv[0], invB = 1.f / stB.lv[0]; const size_t tokA = tokb + qA0 + 16 * wave + (lane & 15), tokB = tokb + qB0 + 16 * wave + (lane & 15);
#pragma unroll
          for (int ne = 0; ne < 8; ++ne) { u32x2 w; w.x = pk2(stA.o[ne][0] * invA, stA.o[ne][1] * invA); w.y = pk2(stA.o[ne][2] * invA, stA.o[ne][3] * invA);
              *(u32x2*)(cat + tokA * 1024 + 512 + h * 128 + 16 * ne + 4 * (lane >> 4)) = w;
              w.x = pk2(stB.o[ne][0] * invB, stB.o[ne][1] * invB); w.y = pk2(stB.o[ne][2] * invB, stB.o[ne][3] * invB);
              *(u32x2*)(cat + tokB * 1024 + 512 + h * 128 + 16 * ne + 4 * (lane >> 4)) = w; } }
    }
}

__device__ __forceinline__ void ph_khat(int WV_, const bf16_t* mkv, const float* kg, const float* qg, bf16_t* khat, int wg, int nwg) {
    const int tid = otid(), lane = tid & 63, wave = __builtin_amdgcn_readfirstlane(tid >> 6);
    const f32x4 g4 = *(const f32x4*)(kg + 4 * lane), q4 = *(const f32x4*)(qg + 4 * lane);
    const int jstride = nwg * 8;
    for (int job0 = wg * 8 + wave; job0 < BATCH * NMEM * 4; job0 += 4 * jstride) {
        u32x2 wv[4];
#pragma unroll
        for (int k = 0; k < 4; ++k) { const int job = job0 + k * jstride; wv[k] = (u32x2){0u, 0u}; if (job < BATCH * NMEM * 4) wv[k] = *(const u32x2*)(mkv + (size_t)(job >> 2) * 2048 + (job & 3) * 256 + 4 * lane); }
#pragma unroll
        for (int k = 0; k < 4; ++k) { const int job = job0 + k * jstride; const int row = job >> 2, hh = job & 3; const u32x2 w = wv[k];
            const float x0 = bflo(w.x), x1 = bfhi(w.x), x2 = bflo(w.y), x3 = bfhi(w.y);
            const float rk = 1.f / sqrtf(wave_sum((x0 * x0 + x1 * x1) + (x2 * x2 + x3 * x3)) * (1.f / 256.f) + EPS);
            u32x2 o; o.x = pk2(x0 * rk * g4.x * q4.x, x1 * rk * g4.y * q4.y); o.y = pk2(x2 * rk * g4.z * q4.z, x3 * rk * g4.w * q4.w);
            if (job < BATCH * NMEM * 4) *(u32x2*)(khat + (size_t)row * 1024 + hh * 256 + 4 * lane) = o; }
    }
}

constexpr int LD256 = 544;
__device__ __forceinline__ void ph_xattn(int WV_, unsigned char* lds, const bf16_t* q, const bf16_t* mkv, const bf16_t* khat, bf16_t* o, int G, int bx) {
    const int tid = otid(), lane = tid & 63, wave = __builtin_amdgcn_readfirstlane(tid >> 6);
    pg8::StaticOrder<T, 1024> SO; SO.init(G, bx);
    for (int it = 0; ; ++it) {
        pg8::Unit un; if (!SO.next(it, un)) break;
        const int h = un.pn, b = un.pm >> 3; const size_t tok0 = (size_t)un.pm * 256 + 32 * wave;
        bf16x8 qa[2][8]; float sc[2];
#pragma unroll
        for (int rt = 0; rt < 2; ++rt) { float ssq = 0.f;
#pragma unroll
            for (int ks = 0; ks < 8; ++ks) { const u32x4 v = *(const u32x4*)(q + (tok0 + 16 * rt + (lane & 15)) * 1024 + h * 256 + 32 * ks + 8 * (lane >> 4));
                float f[8]; unpack8(v, f);
#pragma unroll
                for (int j = 0; j < 8; ++j) ssq += f[j] * f[j];
                qa[rt][ks] = __builtin_bit_cast(bf16x8, v); }
            ssq = sum_rows(ssq);
            sc[rt] = (1.f / sqrtf(ssq * (1.f / 256.f) + EPS)) * (0.0625f * LOG2E); }
        const int m = tid >> 5, part = tid & 31;
        const bf16_t* ksrc = khat + ((size_t)b * NMEM + m) * 1024 + h * 256 + part * 8;
        const bf16_t* vsrc = mkv + ((size_t)b * NMEM + m) * 2048 + 1024 + h * 256 + part * 8;
        u32x4 sr[2][4];
#define XA_SRC(t_, c_) (((t_) < 4) ? ksrc + (size_t)((t_) * 64 + 16 * (c_)) * 1024 : vsrc + (size_t)(((t_) - 4) * 64 + 16 * (c_)) * 2048)
#pragma unroll
        for (int c = 0; c < 4; ++c) { sr[0][c] = *(const u32x4*)XA_SRC(0, c); sr[1][c] = *(const u32x4*)XA_SRC(1, c); }
        bf16x8 pb[2][8]; float l0 = 0.f, l1 = 0.f;
        f32x4 oa[2][16];
        __syncthreads();
#pragma unroll
        for (int ti = 0; ti < 8; ++ti) {
            unsigned char* Tl = lds + (ti & 1) * 64 * LD256;
#pragma unroll
            for (int c = 0; c < 4; ++c) *(u32x4*)(Tl + (m + 16 * c) * LD256 + part * 16) = sr[ti & 1][c];
            if (ti + 2 < 8) {
#pragma unroll
                for (int c = 0; c < 4; ++c) sr[ti & 1][c] = *(const u32x4*)XA_SRC(ti + 2, c); }
            __syncthreads();
            if (ti < 4) {
                f32x4 s0[4], s1[4];
#pragma unroll
                for (int kt = 0; kt < 4; ++kt) { s0[kt] = (f32x4){0.f, 0.f, 0.f, 0.f}; s1[kt] = (f32x4){0.f, 0.f, 0.f, 0.f}; }
#pragma unroll
                for (int ks = 0; ks < 8; ++ks) {
#pragma unroll
                    for (int kt = 0; kt < 4; ++kt) { const bf16x8 kf = frag_row((const LAS unsigned char*)Tl, LD256, 16 * kt, 32 * ks, lane); s0[kt] = MFMA16(kf, qa[0][ks], s0[kt]); s1[kt] = MFMA16(kf, qa[1][ks], s1[kt]); }
                    if ((ks & 1) == 1) __builtin_amdgcn_sched_barrier(0); }
#pragma unroll
                for (int k2 = 0; k2 < 2; ++k2) { float p[8];
#pragma unroll
                    for (int j = 0; j < 8; ++j) { p[j] = fexp2(s0[2 * k2 + (j >> 2)][j & 3] * sc[0]); l0 += p[j]; }
                    u32x4 w = pack8(p); pb[0][2 * (ti & 3) + k2] = __builtin_bit_cast(bf16x8, w);
#pragma unroll
                    for (int j = 0; j < 8; ++j) { p[j] = fexp2(s1[2 * k2 + (j >> 2)][j & 3] * sc[1]); l1 += p[j]; }
                    w = pack8(p); pb[1][2 * (ti & 3) + k2] = __builtin_bit_cast(bf16x8, w); }
            } else {
#pragma unroll
                for (int ne = 0; ne < 16; ++ne) {
#pragma unroll
                    for (int k2 = 0; k2 < 2; ++k2) { const bf16x8 vf = frag_trp((const LAS unsigned char*)Tl, LD256, 32 * k2, 16 * ne, lane); const bool first = (ti == 4 && k2 == 0);
                        oa[0][ne] = MFMA16(vf, pb[0][2 * (ti & 3) + k2], first ? ((f32x4){0.f, 0.f, 0.f, 0.f}) : oa[0][ne]); oa[1][ne] = MFMA16(vf, pb[1][2 * (ti & 3) + k2], first ? ((f32x4){0.f, 0.f, 0.f, 0.f}) : oa[1][ne]); }
                    if ((ne & 3) == 3) __builtin_amdgcn_sched_barrier(0); }
            }
        }
#pragma unroll
        for (int rt = 0; rt < 2; ++rt) { const float inv = 1.f / sum_rows(rt ? l1 : l0); const size_t tok = tok0 + 16 * rt + (lane & 15);
#pragma unroll
            for (int ne = 0; ne < 16; ++ne) { u32x2 w; w.x = pk2(oa[rt][ne][0] * inv, oa[rt][ne][1] * inv); w.y = pk2(oa[rt][ne][2] * inv, oa[rt][ne][3] * inv);
                *(u32x2*)(o + tok * 1024 + h * 256 + 16 * ne + 4 * (lane >> 4)) = w; } }
#undef XA_SRC
    }
}


__global__ void __launch_bounds__(NTHR, 2) hybrid_fwd(Args a) {
    extern __shared__ __attribute__((aligned(16))) unsigned char lds[];
    const int WV_ = __builtin_amdgcn_readfirstlane(threadIdx.x >> 6);
    const int tid = threadIdx.x;
    volatile LAS unsigned* ctlw = (volatile LAS unsigned*)((LAS unsigned char*)lds + LDS_SCRATCH);
    if (tid < 64) ctlw[tid] = 0u;
    __syncthreads();
    XcdBarrier bar; bar.bar = (unsigned*)(a.ws + WS_CTL); bar.x = 0; bar.st = ctlw;
    if (a.hi - a.lo > 1) bar = xcd_barrier_post((unsigned*)(a.ws + WS_CTL), ctlw);
    if (tid == 0) { unsigned* ctl0 = (unsigned*)(a.ws + WS_CTL); if (xb_ld(&ctl0[GB_XCC(blockIdx.x & 255)]) == 0u) (void)xb_add(&ctl0[GB_XCC(blockIdx.x & 255)], xb_xcc_id() + 1u); }
    int ph = 0;
    constexpr int CNT0 = __COUNTER__ + 1;
#define PH_BEGIN if (__builtin_amdgcn_readfirstlane((int)(ph >= arg_lohi(a, 0) && ph < arg_lohi(a, 1)))) { unsigned char* ws = opq(a.ws); float* h = opq(a.out); int oz_ = 0; asm volatile("" : "+s"(oz_)); const int G = (int)gridDim.x + oz_, bx = (int)blockIdx.x + oz_; (void)h; (void)G; (void)bx; \
        bf16_t* hb = (bf16_t*)(ws + WS_XN); bf16_t* cat = (bf16_t*)(ws + WS_CAT); unsigned char* big = ws + WS_BIG; float* ssb = (float*)(ws + WS_SS); (void)hb; (void)cat; (void)big; (void)ssb;
#define PH_END   if (__builtin_amdgcn_readfirstlane((int)(ph + 1 < arg_lohi(a, 1)))) { for (int rep_ = 0; rep_ < REP_BAR; ++rep_) xcd_barrier(bar); } } ph = __builtin_amdgcn_readfirstlane(ph + 1);
#ifndef GEMM_MASK
#define GEMM_MASK 0xffffffffu
#endif
#define GEMM_RUN(Epi_, E_, A_, Bt_, M_, N_, K_, lda_, ldb_) if constexpr ((GEMM_MASK >> (__COUNTER__ - CNT0)) & 1u) { pg8::Gemm g{(A_), (Bt_)}; pg8::StaticOrder<M_, N_> S; S.init(G, bx); pg8::gemm_phase<Epi_, M_, N_, K_, lda_, ldb_>(WV_, (LAS unsigned char*)lds, g, S, (E_)); }
#define KHAT_RUN(wg_, nwg_) for (int rep_ = 0; rep_ < REP_KHAT; ++rep_) ph_khat(WV_, (const bf16_t*)(ws + WS_MKV), inp(a, I_XKG) + L * 256, inp(a, I_XQG) + L * 256, (bf16_t*)(ws + WS_MEMN), (wg_), (nwg_));

    PH_BEGIN
#ifndef SKIP_PRO
        for (int rep_ = 0; rep_ < REP_PRO; ++rep_) ph_prologue(WV_, a, lds);
#endif
    PH_END
    for (int L_ = 0; L_ < DEPTH; ++L_) {
        const int L = __builtin_amdgcn_readfirstlane(L_), j = L >> 1;
#define ODD_PTRS bf16_t* z = (bf16_t*)big; float* gates = (float*)(ws + WS_GATES); bf16_t* kv = (bf16_t*)(ws + WS_KV); float* nloc = (float*)(ws + WS_NLOC); \
            float* mloc = (float*)(ws + WS_MLOC); float* gsum = (float*)(ws + WS_GSUM); float* ms = (float*)(ws + WS_MS); float* ksum = (float*)(ws + WS_KSUM); \
            (void)z; (void)gates; (void)kv; (void)nloc; (void)mloc; (void)gsum; (void)ms; (void)ksum;
        PH_BEGIN {
            if ((L & 1) == 0) { pg8::EpiBf16<1> E{(bf16_t*)big, 1024, 4, (bf16_t*)(big + (size_t)T * 1024 * 2), 512, ssb, -1, nullptr};
                for (int rep_ = 0; rep_ < REP_GIN; ++rep_) GEMM_RUN(pg8::EpiBf16<1>, E, hb, (const bf16_t*)(ws + WS_WEVIN) + (size_t)j * 1536 * 1024, T, 1536, 1024, 1024, 1024)
                if (L == 0) {
                    pg8::EpiBf16<0> E2{(bf16_t*)(ws + WS_MKV), 2048, 1 << 30, nullptr, 0, nullptr, -1, nullptr};
                    pg8::Gemm g2{(const bf16_t*)(ws + WS_MEMN), (const bf16_t*)(ws + WS_WMKV)}; pg8::StaticOrder<BATCH * NMEM, 2048> S2; S2.init(G, (bx + G - (G >> 1)) % G);
                    pg8::gemm_phase<pg8::EpiBf16<0>, BATCH * NMEM, 2048, 1024, 1024, 1024>(WV_, (LAS unsigned char*)lds, g2, S2, E2); }
            } else { ODD_PTRS pg8::EpiBf16<0> E{z, ODD_N, 1 << 30, nullptr, 0, ssb, 14, gates};
                for (int rep_ = 0; rep_ < REP_GIN; ++rep_) GEMM_RUN(pg8::EpiBf16<0>, E, hb, (const bf16_t*)(ws + WS_WODIN) + (size_t)j * ODD_NP * 1024, T, ODD_NP, 1024, 1024, 1024) }
            { const int i0 = ((L & 1) == 0 && L > 0) ? 128 : 192;
              if (G == 256 && bx >= i0) { if (L > 0) { KHAT_RUN(bx - i0, 256 - i0) }
                  if (L + 1 < DEPTH) convert_layer(a, ws, (float*)(lds + WV_ * 16384), olane(), L + 1, 0, (bx - i0) * 8 + WV_, (256 - i0) * 8, conv_share0(L, G)); } }
        } PH_END
        if ((L & 1) == 0) {
            PH_BEGIN {
#ifndef SKIP_S5
                for (int rep_ = 0; rep_ < REP_S5; ++rep_)
                ph_s5(WV_, lds, (const bf16_t*)(big + (size_t)T * 1024 * 2), (bf16_t*)(big + (size_t)T * 1536 * 2), (const float*)(ws + WS_LAMB) + j * 32 * 64 * 2, (const float*)(ws + WS_BBAR) + (size_t)j * 32 * 64 * 16 * 2,
                      inp(a, I_CRE) + (size_t)j * 32 * 16 * 64, inp(a, I_CIM) + (size_t)j * 32 * 16 * 64, inp(a, I_S5D) + j * 512);
#endif
            } PH_END
        } else {
            PH_BEGIN ODD_PTRS {
#ifndef SKIP_MPREP
                ph_moba_prep(WV_, lds, z, inp(a, I_MBQG) + j * 128, inp(a, I_MBKG) + j * 128, ksum);
#endif
#ifndef SKIP_M1
                for (int rep_ = 0; rep_ < REP_M1; ++rep_)
                ph_mlstm1(WV_, lds, z, gates, inp(a, I_BIF) + j * 8, inp(a, I_CONVW) + (size_t)j * 4 * 1024, inp(a, I_CONVB) + j * 1024, kv, nloc, mloc, gsum);
#endif
            } PH_END
            PH_BEGIN ODD_PTRS { ph_mlstm2(WV_, kv, nloc, mloc, gsum, ms); if (G != 256) { KHAT_RUN(bx, G) } } PH_END
            PH_BEGIN ODD_PTRS {
#ifndef SKIP_M3
                for (int rep_ = 0; rep_ < REP_M3; ++rep_)
                ph_mlstm3(WV_, lds, z, gates, inp(a, I_BIF) + j * 8, inp(a, I_CONVW) + (size_t)j * 4 * 1024, inp(a, I_CONVB) + j * 1024, kv, nloc, ms, inp(a, I_HNG) + j * 512, cat);
#endif
#ifndef SKIP_MATTN
                for (int rep_ = 0; rep_ < REP_MATTN; ++rep_)
                ph_moba_attn(WV_, lds, z, ksum, cat);
#endif
            } PH_END
        }
#define MOE_IDX ((int*)(big + ((size_t)64 << 20)))
#define MOE_GS ((float*)(big + ((size_t)66 << 20)))
#define MOE_RSL ((float*)(big + ((size_t)70 << 20)))
        PH_BEGIN {
            pg8::Unit myu; myu.pm = 8 * (bx & 7) + ((bx >> 3) & 7); myu.pn = (bx >> 6) & 3;
            const bool grp = (G == 256);
            unsigned same = 0u;
            if (grp) { unsigned* ctl = (unsigned*)ws; const unsigned x0 = xb_ld(&ctl[GB_XCC(bx & 63)]), x1 = xb_ld(&ctl[GB_XCC((bx & 63) + 64)]), x2 = xb_ld(&ctl[GB_XCC((bx & 63) + 128)]), x3 = xb_ld(&ctl[GB_XCC((bx & 63) + 192)]);
                same = __builtin_amdgcn_readfirstlane((x0 != 0u && x0 == x1 && x0 == x2 && x0 == x3) ? 1u : 0u); }
            const int even = ((L & 1) == 0) ? 1 : 0; const unsigned kbase = (unsigned)(3 * L + ((L + 1) >> 1)); unsigned kuse = 0u;
#define SEAM(s_) { if (grp) group_sync((unsigned*)ws, myu.pm, kbase + kuse, same); else xcd_barrier(bar); kuse += 1u; }
            if (even) { pg8::EpiGlu E{(const bf16_t*)(big + (size_t)T * 1536 * 2), 512, inp(a, I_BGLU) + j * 512, cat, 1024, 512};
                if (grp) { pg8::Gemm gg{(const bf16_t*)(big + (size_t)T * 1536 * 2), (const bf16_t*)(ws + WS_WGLU) + (size_t)j * 512 * 512}; pg8::OneUnit SG{myu.pm, myu.pn, myu.pn < 2};
                    pg8::gemm_phase<pg8::EpiGlu, T, 512, 512, 512, 512>(WV_, (LAS unsigned char*)lds, gg, SG, E);
#ifndef SKIP_GMLP
                    if (myu.pn >= 2) {
#pragma unroll 1
                        for (int hh = 0; hh < 2; ++hh) ph_gmlp(WV_, lds, (const bf16_t*)big, cat, (const bf16_t*)(ws + WS_GMW) + (size_t)j * 4 * 128 * 128, inp(a, I_GMBS) + j * 512, inp(a, I_GMLN) + j * 512, 8 * myu.pm + 2 * (myu.pn - 2) + hh, 4, 8 * myu.pm + 8); }
#endif
                } else { GEMM_RUN(pg8::EpiGlu, E, (const bf16_t*)(big + (size_t)T * 1536 * 2), (const bf16_t*)(ws + WS_WGLU) + (size_t)j * 512 * 512, T, 512, 512, 512, 512)
                    ph_gmlp(WV_, lds, (const bf16_t*)big, cat, (const bf16_t*)(ws + WS_GMW) + (size_t)j * 4 * 128 * 128, inp(a, I_GMBS) + j * 512, inp(a, I_GMLN) + j * 512, bx, G); }
                if (L == 0 || G != 256) { KHAT_RUN(bx, G) }
                SEAM(0) }
            for (int rep_ = 0; rep_ < REP_RES; ++rep_) { pg8::EpiResAddN E{nullptr, hb, ssb + (size_t)T * 16, (rep_ == REP_RES - 1) ? 1.f : 0.f};
                const bf16_t* wout = ((L & 1) == 0) ? (const bf16_t*)(ws + WS_WEVOUT) + (size_t)j * 1024 * 1024 : (const bf16_t*)(ws + WS_WODOUT) + (size_t)j * 1024 * 1024;
                GEMM_RUN(pg8::EpiResAddN, E, cat, wout, T, 1024, 1024, 1024, 1024) }
            SEAM(0)
            { pg8::EpiBf16<0> E{(bf16_t*)big, 1024, 1 << 30, nullptr, 0, ssb + (size_t)T * 16, -1, nullptr};
              GEMM_RUN(pg8::EpiBf16<0>, E, hb, (const bf16_t*)(ws + WS_WXQ) + (size_t)L * 1024 * 1024, T, 1024, 1024, 1024, 1024)
#ifndef SKIP_XATTN
              ph_xattn(WV_, lds, (const bf16_t*)big, (const bf16_t*)(ws + WS_MKV), (const bf16_t*)(ws + WS_MEMN), (bf16_t*)(big + (size_t)T * 1024 * 2), G, bx);
#endif
            }
            SEAM(1)
            for (int rep_ = 0; rep_ < REP_RES; ++rep_) { pg8::EpiResAddN E{nullptr, hb, nullptr, (rep_ == REP_RES - 1) ? 1.f : 0.f};
                GEMM_RUN(pg8::EpiResAddN, E, (const bf16_t*)(big + (size_t)T * 1024 * 2), (const bf16_t*)(ws + WS_WXO) + (size_t)L * 1024 * 1024, T, 1024, 1024, 1024, 1024) }
            SEAM(2)
            for (int rep_ = 0; rep_ < REP_ROUTER; ++rep_) ph_router(WV_, lds, hb, (const bf16_t*)(ws + WS_WRB) + (size_t)L * 2 * 32 * 1024, inp(a, I_BGRP) + L * 4, inp(a, I_BEXP) + L * 16,
                           (int*)(ws + WS_MCNT) + L * 32 + (REP_ROUTER - 1 - rep_) * 128, (rep_ == REP_ROUTER - 1) ? MOE_IDX : (int*)(big + ((size_t)80 << 20)), (rep_ == REP_ROUTER - 1) ? MOE_GS : (float*)(big + ((size_t)82 << 20)), (rep_ == REP_ROUTER - 1) ? MOE_RSL : (float*)(big + ((size_t)86 << 20)),
                           grp ? 4 * myu.pm + myu.pn : bx, grp ? T / 64 : G);
#undef SEAM
        } PH_END
#define MOE_PHASE(UA, UB, DA, DB) { pg8::MoeOrder2 S; S.init(G, bx, (const int*)(ws + WS_MCNT) + L * 32, olane(), (LAS unsigned char*)lds); const int Rt = S.mtot; (void)Rt; S.range(UA, UB, DA, DB); \
            BselMoe2 bs{(const bf16_t*)(ws + WS_WUP) + (size_t)(L * 2) * 4096 * 1024, (const bf16_t*)(ws + WS_WDN) + (size_t)L * 1024 * 4096}; \
            pg8::EpiMoeUpP EU{(bf16_t*)big, MOE_GS, MOE_RSL}; pg8::EpiMoeDownP ED{(L == DEPTH - 1) ? h : (float*)nullptr, MOE_IDX, hb, ssb}; \
            pg8::gemm_phase_moe2<pg8::EpiMoeUpP, pg8::EpiMoeDownP>(WV_, (LAS unsigned char*)lds, hb, (const bf16_t*)big, MOE_IDX, S, bs, EU, ED); }
        PH_BEGIN MOE_PHASE(0, 64, 0, 0) PH_END
#define MOE_CONV_SPLIT pg8::MoeOrder2 S2; S2.init(G, bx, (const int*)(ws + WS_MCNT) + L * 32, olane(), (LAS unsigned char*)lds); const int nu = (S2.mtot - 64) * 4, wB = 2 * (G - nu), wC = 3 * (G - 2 * nu); \
            const int n0 = conv_share0(L, G); const int n1 = n0 + ((wC > 0) ? ((wc::layer_items(L + 1) - n0) * wB) / (wB + wC) : wc::layer_items(L + 1) - n0); (void)n1;
        PH_BEGIN { MOE_PHASE(64, Rt, 0, 128 - Rt)
            if (L + 1 < DEPTH) { MOE_CONV_SPLIT
                if (S2.c >= nu) convert_layer(a, ws, (float*)(lds + WV_ * 16384), olane(), L + 1, n0, (S2.c - nu) * 8 + WV_, (G - nu) * 8, n1); } } PH_END
        PH_BEGIN { MOE_PHASE(0, 0, 128 - Rt, Rt)
            if (L + 1 < DEPTH) { MOE_CONV_SPLIT
                if (S2.c >= 2 * nu) convert_layer(a, ws, (float*)(lds + WV_ * 16384), olane(), L + 1, n1, (S2.c - 2 * nu) * 8 + WV_, (G - 2 * nu) * 8); } } PH_END
    }
#undef PH_BEGIN
#undef PH_END
}

constexpr int NPH = 1 + 2 * (2 + 1 + 3) + 2 * (4 + 1 + 3);

extern "C" void kernel_launch(void* const* d_in, const int* in_sizes, int n_in, void* d_out, int out_size, void* d_ws, size_t ws_size, hipStream_t stream) {
    static int grid = 0;
    if (grid == 0) {
        if (n_in != 41 || out_size != T * D || ws_size < WS_END) { fprintf(stderr, "kernel_launch: unexpected shapes (n_in %d out %d ws %zu need %zu)\n", n_in, out_size, ws_size, (size_t)WS_END); grid = -1; return; }
        int dev = 0, cus = 0, per_cu = 0;
        if (hipGetDevice(&dev) != hipSuccess || hipDeviceGetAttribute(&cus, hipDeviceAttributeMultiprocessorCount, dev) != hipSuccess) { grid = -1; return; }
        if (hipFuncSetAttribute((const void*)hybrid_fwd, hipFuncAttributeMaxDynamicSharedMemorySize, LDS_BYTES) != hipSuccess) { fprintf(stderr, "kernel_launch: hipFuncSetAttribute failed\n"); grid = -1; return; }
        if (hipOccupancyMaxActiveBlocksPerMultiprocessor(&per_cu, (const void*)hybrid_fwd, NTHR, LDS_BYTES) != hipSuccess || per_cu < 1) { fprintf(stderr, "kernel_launch: occupancy query says %d\n", per_cu); }
        (void)hipGetLastError();
        grid = cus;
    }
    if (grid < 0) return;
    (void)hipMemsetAsync((char*)d_ws + WS_CTL, 0, CTL_BYTES, stream);
    Args a{};
    for (int i = 0; i < 41; ++i) a.in[i] = (const float*)d_in[i];
    a.out = (float*)d_out; a.ws = (unsigned char*)d_ws;
#if MK_PER_PHASE
    for (int p = 0; p < NPH; ++p) { a.lo = p; a.hi = p + 1; hipLaunchKernelGGL(hybrid_fwd, dim3(grid), dim3(NTHR), LDS_BYTES, stream, a); }
#else
    a.lo = 0; a.hi = NPH; hipLaunchKernelGGL(hybrid_fwd, dim3(grid), dim3(NTHR), LDS_BYTES, stream, a);
#endif
}
```

```cpp
#include <hip/hip_runtime.h>
#include <cstdio>
#include <cstdint>

#ifndef REP_NORM
#define REP_NORM 1
#endif
#ifndef REP_PRO
#define REP_PRO 1
#endif
#ifndef REP_BAR
#define REP_BAR 1
#endif
#ifndef REP_GIN
#define REP_GIN 1
#endif
#ifndef REP_UP
#define REP_UP 1
#endif
#ifndef REP_ROUTER
#define REP_ROUTER 1
#endif
#ifndef REP_KHAT
#define REP_KHAT 1
#endif
#ifndef REP_RES
#define REP_RES 1
#endif
#ifndef REP_DN
#define REP_DN 1
#endif
#ifndef REP_UPG
#define REP_UPG 1
#endif
#ifndef REP_S5
#define REP_S5 1
#endif
#ifndef REP_GMLP
#define REP_GMLP 1
#endif
#ifndef REP_M1
#define REP_M1 1
#endif
#ifndef REP_M3
#define REP_M3 1
#endif
#ifndef REP_MATTN
#define REP_MATTN 1
#endif
#ifndef REP_XATTN
#define REP_XATTN 1
#endif
#ifndef MK_PER_PHASE
#define MK_PER_PHASE 0
#endif

#define LAS __attribute__((address_space(3)))
typedef unsigned short bf16_t;
typedef short bf16x8 __attribute__((ext_vector_type(8)));
typedef short s16x4 __attribute__((ext_vector_type(4)));
typedef float f32x4 __attribute__((ext_vector_type(4)));
typedef float f32x2 __attribute__((ext_vector_type(2)));
typedef unsigned u32x4 __attribute__((ext_vector_type(4)));
typedef unsigned u32x2 __attribute__((ext_vector_type(2)));
typedef __bf16 bf16x2_t __attribute__((ext_vector_type(2)));

constexpr int D = 1024, BATCH = 8, SEQ = 2048, T = BATCH * SEQ, DEPTH = 4;
constexpr int MIX = 512, NMEM = 256, NTHR = 512;
constexpr int EVEN_IN = 1536, ODD_IN = 3592, ODD_N = 3584, ODD_NP = 3840;
constexpr float EPS = 1e-6f;
constexpr float LOG2E = 1.4426950408889634f;

constexpr size_t al256(size_t x) { return (x + 255) & ~(size_t)255; }
constexpr size_t WS_CTL = 0;
constexpr size_t CTL_BYTES = 16384;
constexpr size_t WS_WMKV = WS_CTL + CTL_BYTES;
constexpr size_t WS_WXQ = WS_WMKV + (size_t)2048 * 1024 * 2;
constexpr size_t WS_WXO = WS_WXQ + (size_t)4 * 1024 * 1024 * 2;
constexpr size_t WS_WUP = WS_WXO + (size_t)4 * 1024 * 1024 * 2;
constexpr size_t WS_WDN = WS_WUP + (size_t)8 * 4096 * 1024 * 2;
constexpr size_t WS_WEVIN = WS_WDN + (size_t)4 * 1024 * 4096 * 2;
constexpr size_t WS_WEVOUT = WS_WEVIN + (size_t)2 * 1536 * 1024 * 2;
constexpr size_t WS_WGLU = WS_WEVOUT + (size_t)2 * 1024 * 1024 * 2;
constexpr size_t WS_WODIN = WS_WGLU + (size_t)2 * 512 * 512 * 2;
constexpr size_t WS_WODOUT = WS_WODIN + (size_t)2 * 3840 * 1024 * 2;
constexpr size_t WS_GMW = WS_WODOUT + (size_t)2 * 1024 * 1024 * 2;
constexpr size_t WS_WRT = WS_GMW + (size_t)2 * 4 * 128 * 128 * 2;
constexpr size_t WS_WIFT = WS_WRT + (size_t)4 * 20 * 1024 * 4;
constexpr size_t WS_LAMB = WS_WIFT + (size_t)2 * 8 * 1024 * 4;
constexpr size_t WS_BBAR = WS_LAMB + (size_t)2 * 32 * 64 * 2 * 4;
constexpr size_t WS_KSUM = WS_BBAR + (size_t)2 * 32 * 64 * 16 * 2 * 4;
constexpr size_t WS_GATES = WS_KSUM + (size_t)8 * 4 * 8 * 128 * 4;
constexpr size_t WS_GATEW = WS_GATES + (size_t)T * 8 * 4;
constexpr size_t WS_MIDX = WS_GATEW + (size_t)T * 16 * 4;
constexpr size_t WS_MCNT = WS_MIDX + (size_t)4 * T * 4;
constexpr size_t WS_WRB = WS_MCNT + 4096;
constexpr size_t WS_MLOC = WS_WRB + (size_t)4 * 2 * 32 * 1024 * 2;
constexpr size_t WS_GSUM = WS_MLOC + 2048;
constexpr size_t WS_MS = WS_GSUM + 2048;
constexpr size_t WS_NLOC = WS_MS + 2048;
constexpr size_t WS_MEMN = WS_NLOC + (size_t)512 * 128 * 4;
constexpr size_t WS_MKV = WS_MEMN + (size_t)2048 * 1024 * 2;
constexpr size_t WS_XN = WS_MKV + (size_t)2048 * 2048 * 2;
constexpr size_t WS_CAT = WS_XN + (size_t)T * 1024 * 2;
constexpr size_t WS_SS = WS_CAT + (size_t)T * 1024 * 2;
constexpr size_t WS_RSTD = WS_SS + (size_t)2 * T * 16 * 4;
constexpr size_t WS_RSL = WS_RSTD + (size_t)T * 4;
constexpr size_t WS_BIG = WS_RSL + (size_t)4 * T * 4;
constexpr size_t WS_KV = WS_BIG + (size_t)T * 3584 * 2;
constexpr size_t WS_END = WS_KV + (size_t)512 * 128 * 128 * 2;

#define otid() ((WV_ << 6) | olane())
__device__ __forceinline__ unsigned pk2(float lo, float hi) { f32x2 v = {lo, hi}; bf16x2_t b = __builtin_convertvector(v, bf16x2_t); return __builtin_bit_cast(unsigned, b); }
__device__ __forceinline__ bf16_t f2bf(float f) { return (bf16_t)(pk2(f, 0.f) & 0xffffu); }
__device__ __forceinline__ float bf2f(unsigned b) { return __uint_as_float(b << 16); }
__device__ __forceinline__ float bflo(unsigned w) { return __uint_as_float(w << 16); }
__device__ __forceinline__ float bfhi(unsigned w) { return __uint_as_float(w & 0xffff0000u); }
__device__ __forceinline__ float fexp2(float x) { return __builtin_amdgcn_exp2f(x); }
__device__ __forceinline__ float fexp(float x) { return __builtin_amdgcn_exp2f(x * LOG2E); }
__device__ __forceinline__ float frcp(float x) { return __builtin_amdgcn_rcpf(x); }
__device__ __forceinline__ float sigmoidf_(float x) { return frcp(1.f + fexp(-x)); }
__device__ __forceinline__ float siluf_(float x) { return x * sigmoidf_(x); }
__device__ __forceinline__ float gelu_tanh(float x) { const float y = 1.5957691216057308f * (x + 0.044715f * x * x * x); return x * sigmoidf_(y); }
__device__ __forceinline__ float logsigmoidf_(float x) { return fminf(x, 0.f) - __logf(1.f + fexp(-fabsf(x))); }
template <class P> __device__ __forceinline__ P* opq(P* p) { int z_ = 0; asm volatile("" : "+s"(z_)); return p + z_; }
__device__ __forceinline__ int olane() { unsigned z_ = 0u; asm volatile("" : "+v"(z_)); return (int)__builtin_amdgcn_mbcnt_hi(~0u, __builtin_amdgcn_mbcnt_lo(~0u, z_)); }
__device__ __forceinline__ float shx(float v, int o) { return __builtin_bit_cast(float, __builtin_amdgcn_ds_bpermute((olane() ^ o) << 2, __builtin_bit_cast(int, v))); }
__device__ __forceinline__ float shf(float v, int src) { return __builtin_bit_cast(float, __builtin_amdgcn_ds_bpermute(src << 2, __builtin_bit_cast(int, v))); }
template <int CTRL> __device__ __forceinline__ float dppf(float v) { return __builtin_bit_cast(float, __builtin_amdgcn_update_dpp(0, __builtin_bit_cast(int, v), CTRL, 0xf, 0xf, false)); }
__device__ __forceinline__ float xor1f(float v) { return dppf<0xB1>(v); }
__device__ __forceinline__ float xor2f(float v) { return dppf<0x4E>(v); }
__device__ __forceinline__ float xor16f(float v) { return __builtin_bit_cast(float, __builtin_amdgcn_ds_swizzle(__builtin_bit_cast(int, v), 0x401F)); }
__device__ __forceinline__ float sum_x32(float v) { const int iv = __builtin_bit_cast(int, v); auto r = __builtin_amdgcn_permlane32_swap(iv, iv, false, false); return __builtin_bit_cast(float, (int)r[0]) + __builtin_bit_cast(float, (int)r[1]); }
__device__ __forceinline__ float max_x32(float v) { const int iv = __builtin_bit_cast(int, v); auto r = __builtin_amdgcn_permlane32_swap(iv, iv, false, false); return fmaxf(__builtin_bit_cast(float, (int)r[0]), __builtin_bit_cast(float, (int)r[1])); }
__device__ __forceinline__ float sum4(float v) { v += xor1f(v); v += xor2f(v); return v; }
__device__ __forceinline__ float sum8(float v) { v = sum4(v); v += dppf<0x141>(v); return v; }
__device__ __forceinline__ float sum16(float v) { v = sum8(v); v += dppf<0x140>(v); return v; }
template <int CTRL, int RM, int BM> __device__ __forceinline__ float dppm(float old, float v) { return __builtin_bit_cast(float, __builtin_amdgcn_update_dpp(__builtin_bit_cast(int, old), __builtin_bit_cast(int, v), CTRL, RM, BM, false)); }
__device__ __forceinline__ float wave_scan_add(float v) {
    float s = v + dppm<0x111, 0xf, 0xf>(0.f, v);
    s += dppm<0x112, 0xf, 0xf>(0.f, v);
    s += dppm<0x113, 0xf, 0xf>(0.f, v);
    s += dppm<0x114, 0xf, 0xe>(0.f, s);
    s += dppm<0x118, 0xf, 0xc>(0.f, s);
    s += dppm<0x142, 0xa, 0xf>(0.f, s);
    s += dppm<0x143, 0xc, 0xf>(0.f, s);
    return s;
}
__device__ __forceinline__ float wave_scan_max(float v) {
    constexpr float NI = -3.0e38f;
    float s = fmaxf(v, dppm<0x111, 0xf, 0xf>(NI, v));
    s = fmaxf(s, dppm<0x112, 0xf, 0xf>(NI, v));
    s = fmaxf(s, dppm<0x113, 0xf, 0xf>(NI, v));
    s = fmaxf(s, dppm<0x114, 0xf, 0xe>(NI, s));
    s = fmaxf(s, dppm<0x118, 0xf, 0xc>(NI, s));
    s = fmaxf(s, dppm<0x142, 0xa, 0xf>(NI, s));
    s = fmaxf(s, dppm<0x143, 0xc, 0xf>(NI, s));
    return s;
}
__device__ __forceinline__ float wave_shr1(float old, float v) { return dppm<0x138, 0xf, 0xf>(old, v); }
__device__ __forceinline__ float max16(float v) { v = fmaxf(v, xor1f(v)); v = fmaxf(v, xor2f(v)); v = fmaxf(v, dppf<0x141>(v)); v = fmaxf(v, dppf<0x140>(v)); return v; }
__device__ __forceinline__ float sum_rows(float v) { v += xor16f(v); return sum_x32(v); }
__device__ __forceinline__ float wave_sum(float v) { return sum_rows(sum16(v)); }
__device__ __forceinline__ void unpack8(const u32x4 v, float (&f)[8]) { f[0] = bflo(v.x); f[1] = bfhi(v.x); f[2] = bflo(v.y); f[3] = bfhi(v.y); f[4] = bflo(v.z); f[5] = bfhi(v.z); f[6] = bflo(v.w); f[7] = bfhi(v.w); }
__device__ __forceinline__ u32x4 zero4() { unsigned z; asm volatile("v_mov_b32 %0, 0" : "=v"(z)); return (u32x4){z, z, z, z}; }
__device__ __forceinline__ u32x4 pack8(const float (&f)[8]) { u32x4 v; v.x = pk2(f[0], f[1]); v.y = pk2(f[2], f[3]); v.z = pk2(f[4], f[5]); v.w = pk2(f[6], f[7]); return v; }

__device__ __forceinline__ bf16x8 frag_row(const LAS unsigned char* base, int ld, int row0, int k0, int lane) {
    return *(const LAS bf16x8*)(base + (row0 + (lane & 15)) * ld + (k0 + 8 * (lane >> 4)) * 2);
}
__device__ __forceinline__ bf16x8 frag_tr(const LAS unsigned char* base, int ld, int k0, int col0, int lane) {
    const int g = lane >> 4, q = (lane & 15) >> 2, p = lane & 3;
    const LAS unsigned char* a = base + (k0 + 8 * g + q) * ld + (col0 + 4 * p) * 2;
    const s16x4 v0 = __builtin_amdgcn_ds_read_tr16_b64_v4i16((LAS s16x4*)a);
    const s16x4 v1 = __builtin_amdgcn_ds_read_tr16_b64_v4i16((LAS s16x4*)(a + 4 * ld));
    return (bf16x8){v0[0], v0[1], v0[2], v0[3], v1[0], v1[1], v1[2], v1[3]};
}
#define MFMA16(a, b, c) __builtin_amdgcn_mfma_f32_16x16x32_bf16((a), (b), (c), 0, 0, 0)

__device__ __forceinline__ void stage_tile(unsigned char* dst, int dld, const bf16_t* src, size_t sld, int rows, int cols, int tid) {
    const int cpr = cols >> 3, n = rows * cpr;
    for (int i = tid; i < n; i += NTHR) { const int r = i / cpr, c = i - r * cpr;
        *(u32x4*)(dst + r * dld + c * 16) = *(const u32x4*)(src + (size_t)r * sld + c * 8); }
}

#define XB_TMO      128
#define XB_XCNT(j)  (256  + 64 * (j))
#define XB_XSUB(j)  (1280 + 64 * (j))
#define XB_XGEN(j)  (2304 + 64 * (j))
#define XB_TOP      3328
#define XB_TOPGEN   3392
#define XCD_BAR_WORDS 3456
#define XB_SPIN_CAP (1u << 21)
__device__ __forceinline__ unsigned xb_ld(unsigned* p)              { return __hip_atomic_load(p, __ATOMIC_RELAXED, __HIP_MEMORY_SCOPE_AGENT); }
__device__ __forceinline__ unsigned xb_add(unsigned* p, unsigned v) { return __hip_atomic_fetch_add(p, v, __ATOMIC_RELAXED, __HIP_MEMORY_SCOPE_AGENT); }
__device__ __forceinline__ unsigned xb_xcc_id() { return (unsigned)__builtin_amdgcn_s_getreg((3 << 11) | 20) & 0xFu; }
#define XB_SPIN(cond, bar) do { unsigned _sp = 0; while (cond) { __builtin_amdgcn_s_sleep(1); \
    if ((++_sp & 255u) == 0u) { if (xb_ld(&(bar)[XB_TMO])) break; if (_sp > XB_SPIN_CAP) { atomicAdd(&(bar)[XB_TMO], 1u); break; } } } } while (0)
struct XcdBarrier { unsigned* bar; unsigned x; volatile LAS unsigned* st; };
__device__ __forceinline__ XcdBarrier xcd_barrier_post(unsigned* bar, volatile LAS unsigned* st) {
    XcdBarrier b; b.bar = bar; b.x = xb_xcc_id(); b.st = st;
    if (threadIdx.x == 0) (void)xb_add(&bar[XB_XCNT(b.x)], 1u);
    return b;
}
__device__ __forceinline__ void xcd_barrier_complete(unsigned* bar, unsigned x, unsigned& nloc, unsigned& nx) {
    const unsigned G = gridDim.x * gridDim.y * gridDim.z;
    unsigned sum, cnt, mine, sp = 0u;
    for (;;) {
        sum = 0u; cnt = 0u; mine = 0u;
#pragma unroll
        for (unsigned j = 0; j < 16; ++j) { const unsigned c = xb_ld(&bar[XB_XCNT(j)]); sum += c; cnt += (c > 0u) ? 1u : 0u; mine = (j == x) ? c : mine; }
        if (sum == G) break;
        __builtin_amdgcn_s_sleep(1);
        if ((++sp & 255u) == 0u) { if (xb_ld(&bar[XB_TMO])) break; if (sp > XB_SPIN_CAP) { atomicAdd(&bar[XB_TMO], 1u); break; } }
    }
    nloc = mine > 0u ? mine : 1u; nx = cnt > 0u ? cnt : 1u;
}
__device__ __forceinline__ void xcd_barrier(const XcdBarrier& b) {
    asm volatile("s_waitcnt vmcnt(0)" ::: "memory");
    __syncthreads();
    if (threadIdx.x == 0) {
        unsigned* bar = opq(b.bar);
        __builtin_amdgcn_s_waitcnt(0);
        unsigned nloc = b.st[0], nx = b.st[1];
        unsigned bx_ = __builtin_amdgcn_readfirstlane(b.x); asm volatile("" : "+s"(bx_));
        if (nloc == 0u) { xcd_barrier_complete(bar, bx_, nloc, nx); b.st[0] = nloc; b.st[1] = nx; }
        const unsigned old = xb_add(&bar[XB_XSUB(bx_)], 1u);
        const unsigned gen = old / nloc;
        if (old + 1u == (gen + 1u) * nloc) {
            __builtin_amdgcn_fence(__ATOMIC_RELEASE, "agent");
            asm volatile("s_waitcnt vmcnt(0)" ::: "memory");
            const unsigned og = xb_add(&bar[XB_TOP], 1u);
            const unsigned tg = og / nx;
            if (og + 1u != (tg + 1u) * nx) XB_SPIN(xb_ld(&bar[XB_TOP]) < (tg + 1u) * nx, bar);
            __builtin_amdgcn_fence(__ATOMIC_ACQUIRE, "agent");
            xb_add(&bar[XB_XGEN(bx_)], 1u);
            asm volatile("s_waitcnt vmcnt(0)" ::: "memory");
        } else {
            XB_SPIN(xb_ld(&bar[XB_XGEN(bx_)]) == gen, bar);
            __builtin_amdgcn_fence(__ATOMIC_ACQUIRE, "agent");
            asm volatile("s_waitcnt vmcnt(0)" ::: "memory");
        }
    }
    __syncthreads();
}

#define XL_BAD 3500
#define XL_CNT(x) (3840 + 16 * (x))
#define GB_XCC(c) (3520 + (c))
#define GB_CNT(g) (3776 + (g))
__device__ __forceinline__ void group_sync(unsigned* ctl, int gid, unsigned k, unsigned same) {
    asm volatile("s_waitcnt vmcnt(0)" ::: "memory");
    __syncthreads();
    if (threadIdx.x == 0) {
        unsigned* c = opq(ctl) + GB_CNT(gid);
        __builtin_amdgcn_s_waitcnt(0);
        if (!same) __builtin_amdgcn_fence(__ATOMIC_RELEASE, "agent");
        asm volatile("s_waitcnt vmcnt(0)" ::: "memory");
        (void)xb_add(c, 1u);
        XB_SPIN(xb_ld(c) < 4u * (k + 1u), opq(ctl));
        __builtin_amdgcn_fence(__ATOMIC_ACQUIRE, "agent");
        asm volatile("s_waitcnt vmcnt(0)" ::: "memory");
    }
    __syncthreads();
}

__device__ __forceinline__ void xcd_local_sync(const XcdBarrier& b) {
    asm volatile("s_waitcnt vmcnt(0)" ::: "memory");
    if (threadIdx.x == 0 && b.st[7] == 0u) b.st[7] = 1u + ((xb_ld(&opq(b.bar)[XL_BAD]) != 0u) ? 1u : 0u);
    __syncthreads();
    if (__builtin_amdgcn_readfirstlane(b.st[7]) != 1u) { xcd_barrier(b); return; }
    if (threadIdx.x == 0) {
        unsigned* bar = opq(b.bar);
        __builtin_amdgcn_s_waitcnt(0);
        const unsigned nloc = b.st[0], k = b.st[6]; b.st[6] = k + 1u;
        unsigned bx_ = __builtin_amdgcn_readfirstlane(b.x); asm volatile("" : "+s"(bx_));
        (void)xb_add(&bar[XL_CNT(bx_)], 1u);
        XB_SPIN(xb_ld(&bar[XL_CNT(bx_)]) < nloc * (k + 1u), bar);
        __builtin_amdgcn_fence(__ATOMIC_ACQUIRE, "agent");
        asm volatile("s_waitcnt vmcnt(0)" ::: "memory");
    }
    __syncthreads();
}
struct Items { int first, count, stride; };

namespace pg8 {
constexpr int BM = 256, BK = 64, HALF = 128, HTB = HALF * BK * 2, STAGE_BYTES = 8 * HTB, NXCD = 8, WGM = 8;
__device__ __forceinline__ int lds_byte(int r, int c) { const int st = (r >> 4) * 2 + (c >> 5), rr = r & 15, cc = c & 31, ob = rr * 64 + cc * 2; return st * 1024 + (ob ^ (((ob >> 9) & 1) << 5)); }
__device__ __forceinline__ void stage_rc(int b, int& R, int& C) { const int st = b / 1024, sb = b % 1024, swz = sb ^ (((sb >> 9) & 1) << 5); R = (st >> 1) * 16 + swz / 64; C = (st & 1) * 32 + (swz % 64) / 2; }
__device__ __forceinline__ int perm32(int rho) { const int n = rho >> 4, i = rho & 15; return 8 * (i >> 2) + 4 * n + (i & 3); }
struct Unit { int pm, pn; };
struct Gemm { const bf16_t* A; const bf16_t* Bt; };
template <int M, int N> struct StaticOrder {
    static constexpr int nM = M / BM, nN = N / BM, nwg = nM * nN;
    int G, c;
    __device__ void init(int G_, int c_) { G = G_; c = c_; }
    __device__ bool next(int i, Unit& u) const {
        const int L = i * G + c; if (L >= nwg) return false;
        int wgid = L; { constexpr int q = nwg / NXCD, r = nwg % NXCD; const int xcd = wgid % NXCD, off = wgid / NXCD; wgid = (xcd < r ? xcd * (q + 1) : r * (q + 1) + (xcd - r) * q) + off; }
        constexpr int nig = WGM * nN; const int gid = wgid / nig, fm = gid * WGM, gsz = (nM - fm) < WGM ? (nM - fm) : WGM;
        u.pm = fm + ((wgid % nig) % gsz); u.pn = (wgid % nig) / gsz; return true;
    }
};

template <class Epi, int M, int N, int K, int LDA, int LDB>
__device__ __forceinline__ void gemm_phase(int WV_, LAS unsigned char* lds, const Gemm g, const StaticOrder<M, N>& S, const Epi& E) {
    const int tid = otid(), wid = __builtin_amdgcn_readfirstlane(tid >> 6), lane = tid & 63, wr = wid >> 2, wc = wid & 3, fr = lane & 15, fq = lane >> 4;
    constexpr int nt = K / BK;
    unsigned voffA[2], voffB[2];
#pragma unroll
    for (int i = 0; i < 2; ++i) { int R, C; stage_rc(tid * 16 + i * 8192, R, C); const int Rb = Epi::PERM ? ((R & ~31) + perm32(R & 31)) : R;
        voffA[i] = (unsigned)(R * LDA + C) * 2u; voffB[i] = (unsigned)(Rb * LDB + C) * 2u; }
    constexpr size_t kstep = (size_t)(BK * 2);
    constexpr size_t hstepA = (size_t)HALF * LDA * 2, hstepB = (size_t)HALF * LDB * 2;
    constexpr size_t tstepA = 2 * hstepA, tstepB = 2 * hstepB;
    const unsigned ldsw = (unsigned)wid * 1024u;
    const int aoff = lds_byte(wr * 64 + fr, fq * 8), boff = lds_byte(wc * 32 + fr, fq * 8);
#define PG8_SA(b, h) (((b) * 2 + (h)) * HTB)
#define PG8_SB(b, h) ((4 + (b) * 2 + (h)) * HTB)
#define PG8_STAGE(bufoff, gbase, voff) do { _Pragma("unroll") for (int _i = 0; _i < 2; ++_i) \
        __builtin_amdgcn_global_load_lds((const unsigned*)((const char*)(gbase) + (voff)[_i]), (LAS unsigned*)(lds + (bufoff) + ldsw + _i * 8192), 16, 0, 0); } while (0)
#define PG8_LDA(dst, b, h) do { _Pragma("unroll") for (int m = 0; m < 4; ++m) _Pragma("unroll") for (int k = 0; k < 2; ++k) dst[m][k] = *(const LAS bf16x8*)(lds + PG8_SA(b, h) + aoff + m * 2048 + k * 1024); } while (0)
#define PG8_LDB(dst, b, h) do { _Pragma("unroll") for (int n = 0; n < 2; ++n) _Pragma("unroll") for (int k = 0; k < 2; ++k) dst[n][k] = *(const LAS bf16x8*)(lds + PG8_SB(b, h) + boff + n * 2048 + k * 1024); } while (0)
#define PG8_MMA(ai, bj, At, Bt) do { __builtin_amdgcn_s_setprio(1); _Pragma("unroll") for (int m = 0; m < 4; ++m) _Pragma("unroll") for (int n = 0; n < 2; ++n) _Pragma("unroll") for (int k = 0; k < 2; ++k) \
        acc[ai][bj][m][n] = __builtin_amdgcn_mfma_f32_16x16x32_bf16(Bt[n][k], At[m][k], acc[ai][bj][m][n], 0, 0, 0); __builtin_amdgcn_s_setprio(0); } while (0)
#define PG8_WAIT_V(n) asm volatile("s_waitcnt vmcnt(" #n ")" ::: "memory")
#define PG8_WAIT_L(n) asm volatile("s_waitcnt lgkmcnt(" #n ")" ::: "memory")
#define PG8_BAR __builtin_amdgcn_s_barrier()
#define PG8_SCHED __builtin_amdgcn_sched_barrier(0)
    Unit cur, nxt; int ui = 0;
    if (!S.next(0, cur)) return;
    f32x4 acc[2][2][4][2];
#pragma unroll
    for (int a = 0; a < 2; ++a)
#pragma unroll
        for (int b = 0; b < 2; ++b)
#pragma unroll
            for (int m = 0; m < 4; ++m)
#pragma unroll
                for (int n = 0; n < 2; ++n) acc[a][b][m][n] = (f32x4){0.f, 0.f, 0.f, 0.f};
    bf16x8 At[4][2], B0[2][2], B1[2][2];
    const char* cA = (const char*)g.A + (size_t)cur.pm * tstepA; const char* cB = (const char*)g.Bt + (size_t)cur.pn * tstepB;
    PG8_STAGE(PG8_SB(0, 0), cB, voffB); PG8_STAGE(PG8_SA(0, 0), cA, voffA); PG8_STAGE(PG8_SB(0, 1), cB + hstepB, voffB); PG8_STAGE(PG8_SA(0, 1), cA + hstepA, voffA);
    if (wr == 1) PG8_BAR;
    PG8_WAIT_V(4); PG8_BAR;
    PG8_STAGE(PG8_SB(1, 0), cB + kstep, voffB); PG8_STAGE(PG8_SA(1, 0), cA + kstep, voffA); PG8_STAGE(PG8_SB(1, 1), cB + hstepB + kstep, voffB);
    PG8_WAIT_V(6); PG8_BAR;
    for (;;) {
        const bool has_next = S.next(ui + 1, nxt);
        const char* nA = has_next ? (const char*)g.A + (size_t)nxt.pm * tstepA : cA; const char* nB = has_next ? (const char*)g.Bt + (size_t)nxt.pn * tstepB : cB;
        for (int t = 0; t < nt; t += 2) {
            const bool last = (t == nt - 2);
            const char* a1 = cA + (size_t)(t + 1) * kstep;
            const char* a2 = last ? nA : cA + (size_t)(t + 2) * kstep; const char* b2 = last ? nB : cB + (size_t)(t + 2) * kstep;
            const char* a3 = a2 + kstep; const char* b3 = b2 + kstep;
            PG8_LDB(B0, 0, 0); PG8_SCHED; PG8_LDA(At, 0, 0); PG8_STAGE(PG8_SA(1, 1), a1 + hstepA, voffA);
            PG8_WAIT_L(8); PG8_BAR; PG8_WAIT_L(0); PG8_MMA(0, 0, At, B0); PG8_BAR; PG8_SCHED;
            PG8_LDB(B1, 0, 1); PG8_STAGE(PG8_SB(0, 0), b2, voffB);
            PG8_BAR; PG8_WAIT_L(0); PG8_MMA(0, 1, At, B1); PG8_BAR;
            PG8_LDA(At, 0, 1); PG8_STAGE(PG8_SA(0, 0), a2, voffA);
            PG8_BAR; PG8_WAIT_L(0); PG8_MMA(1, 0, At, B0); PG8_BAR; PG8_SCHED;
            PG8_STAGE(PG8_SB(0, 1), b2 + hstepB, voffB);
            PG8_WAIT_V(6); PG8_BAR; PG8_MMA(1, 1, At, B1); PG8_BAR;
            PG8_LDB(B0, 1, 0); PG8_SCHED; PG8_LDA(At, 1, 0); PG8_STAGE(PG8_SA(0, 1), a2 + hstepA, voffA);
            PG8_WAIT_L(8); PG8_BAR; PG8_WAIT_L(0); PG8_MMA(0, 0, At, B0); PG8_BAR; PG8_SCHED;
            PG8_LDB(B1, 1, 1); PG8_STAGE(PG8_SB(1, 0), b3, voffB);
            PG8_BAR; PG8_WAIT_L(0); PG8_MMA(0, 1, At, B1); PG8_BAR;
            PG8_LDA(At, 1, 1); PG8_STAGE(PG8_SA(1, 0), a3, voffA);
            PG8_BAR; PG8_WAIT_L(0); PG8_MMA(1, 0, At, B0); PG8_BAR; PG8_SCHED;
            PG8_STAGE(PG8_SB(1, 1), b3 + hstepB, voffB);
            PG8_WAIT_V(6); PG8_BAR; PG8_MMA(1, 1, At, B1); PG8_BAR;
        }
        E(acc, cur, wr, wc, fr, fq);
        if (!has_next) break;
#pragma unroll
        for (int a = 0; a < 2; ++a)
#pragma unroll
            for (int b = 0; b < 2; ++b)
#pragma unroll
                for (int m = 0; m < 4; ++m)
#pragma unroll
                    for (int n = 0; n < 2; ++n) acc[a][b][m][n] = (f32x4){0.f, 0.f, 0.f, 0.f};
        cur = nxt; cA = nA; cB = nB; ++ui;
    }
    PG8_WAIT_V(0);
    if (wr == 0) PG8_BAR;
    PG8_BAR;
#undef PG8_SA
#undef PG8_SB
#undef PG8_STAGE
#undef PG8_LDA
#undef PG8_LDB
#undef PG8_MMA
#undef PG8_WAIT_V
#undef PG8_WAIT_L
#undef PG8_BAR
#undef PG8_SCHED
}

struct EpiResAddN {
    static constexpr bool PERM = true;
    const float* X; bf16_t* HB; float* ss; float scl;
    __device__ __forceinline__ void operator()(const f32x4 (&acc)[2][2][4][2], const Unit& u, int wr, int wc, int fr, int fq) const {
        const int row0 = u.pm * BM + wr * 64 + fr, col0 = u.pn * BM + wc * 32 + 8 * fq;
        if (X) {
#pragma unroll
            for (int ai = 0; ai < 2; ++ai)
#pragma unroll
                for (int m = 0; m < 4; ++m) { const int row = row0 + ai * HALF + m * 16; float sq = 0.f;
#pragma unroll
                    for (int bj = 0; bj < 2; ++bj) { bf16_t* ph = HB + (size_t)row * D + col0 + bj * HALF; float o[8];
                        const float* pi = X + (size_t)row * D + col0 + bj * HALF; const f32x4 a0 = *(const f32x4*)pi, a1 = *(const f32x4*)(pi + 4);
                        o[0] = a0[0]; o[1] = a0[1]; o[2] = a0[2]; o[3] = a0[3]; o[4] = a1[0]; o[5] = a1[1]; o[6] = a1[2]; o[7] = a1[3];
#pragma unroll
                        for (int j = 0; j < 4; ++j) { o[j] += acc[ai][bj][m][0][j] * scl; o[4 + j] += acc[ai][bj][m][1][j] * scl; }
#pragma unroll
                        for (int j = 0; j < 8; ++j) sq += o[j] * o[j];
                        *(u32x4*)ph = pack8(o); }
                    sq = sum_rows(sq);
                    if (fq == 0 && ss) ss[(size_t)row * 16 + u.pn * 4 + wc] = sq; }
        } else {
#pragma unroll
            for (int ai = 0; ai < 2; ++ai) {
                u32x4 old[4][2];
#pragma unroll
                for (int m = 0; m < 4; ++m)
#pragma unroll
                    for (int bj = 0; bj < 2; ++bj) old[m][bj] = *(const u32x4*)(HB + (size_t)(row0 + ai * HALF + m * 16) * D + col0 + bj * HALF);
                __builtin_amdgcn_sched_barrier(0);
#pragma unroll
                for (int m = 0; m < 4; ++m) { const int row = row0 + ai * HALF + m * 16; float sq = 0.f;
#pragma unroll
                    for (int bj = 0; bj < 2; ++bj) { float o[8]; unpack8(old[m][bj], o);
#pragma unroll
                        for (int j = 0; j < 4; ++j) { o[j] += acc[ai][bj][m][0][j] * scl; o[4 + j] += acc[ai][bj][m][1][j] * scl; }
#pragma unroll
                        for (int j = 0; j < 8; ++j) sq += o[j] * o[j];
                        *(u32x4*)(HB + (size_t)row * D + col0 + bj * HALF) = pack8(o); }
                    sq = sum_rows(sq);
                    if (fq == 0 && ss) ss[(size_t)row * 16 + u.pn * 4 + wc] = sq; }
                __builtin_amdgcn_sched_barrier(0);
            }
        }
    }
};
template <int ACT> struct EpiBf16 {
    static constexpr bool PERM = true;
    bf16_t* O1; int ld1; int nsplit; bf16_t* O2; int ld2; const float* ss; int ngate; float* G;
    __device__ __forceinline__ void operator()(const f32x4 (&acc)[2][2][4][2], const Unit& u, int wr, int wc, int fr, int fq) const {
        const int row0 = u.pm * BM + wr * 64 + fr;
        const bool first = u.pn < nsplit;
        bf16_t* base = first ? O1 : O2; const int ld = first ? ld1 : ld2;
        const int col0 = (first ? u.pn : u.pn - nsplit) * BM + wc * 32 + 8 * fq;
        float rsv[2][4];
        if (ss) { f32x4 pp[2][4];
#pragma unroll
            for (int ai = 0; ai < 2; ++ai)
#pragma unroll
                for (int m = 0; m < 4; ++m) pp[ai][m] = *(const f32x4*)(ss + (size_t)(row0 + ai * HALF + m * 16) * 16 + 4 * fq);
            __builtin_amdgcn_sched_barrier(0);
#pragma unroll
            for (int ai = 0; ai < 2; ++ai)
#pragma unroll
                for (int m = 0; m < 4; ++m) { const float tot = sum_rows((pp[ai][m][0] + pp[ai][m][1]) + (pp[ai][m][2] + pp[ai][m][3])); rsv[ai][m] = 1.f / sqrtf(tot * (1.f / 1024.f) + EPS); }
        } else {
#pragma unroll
            for (int ai = 0; ai < 2; ++ai)
#pragma unroll
                for (int m = 0; m < 4; ++m) rsv[ai][m] = 1.f; }
#pragma unroll
        for (int ai = 0; ai < 2; ++ai)
#pragma unroll
            for (int m = 0; m < 4; ++m) { const int row = row0 + ai * HALF + m * 16;
                const float rs = rsv[ai][m];
                if (u.pn == ngate) { if (wc == 0 && fq == 0) { *(f32x4*)(G + (size_t)row * 8) = acc[ai][0][m][0] * rs; *(f32x4*)(G + (size_t)row * 8 + 4) = acc[ai][0][m][1] * rs; } }
                else { bf16_t* rowp = base + (size_t)row * ld + col0;
#pragma unroll
                for (int bj = 0; bj < 2; ++bj) { f32x4 v0 = acc[ai][bj][m][0] * rs, v1 = acc[ai][bj][m][1] * rs;
                    if (ACT == 1 && first) {
#pragma unroll
                        for (int j = 0; j < 4; ++j) { v0[j] = gelu_tanh(v0[j]); v1[j] = gelu_tanh(v1[j]); } }
                    u32x4 w; w.x = pk2(v0[0], v0[1]); w.y = pk2(v0[2], v0[3]); w.z = pk2(v1[0], v1[1]); w.w = pk2(v1[2], v1[3]);
                    *(u32x4*)(rowp + bj * HALF) = w; } } }
    }
};
struct EpiGlu {
    static constexpr bool PERM = true;
    const bf16_t* Y; int ldy; const float* bias; bf16_t* O; int ldo; int ocol0;
    __device__ __forceinline__ void operator()(const f32x4 (&acc)[2][2][4][2], const Unit& u, int wr, int wc, int fr, int fq) const {
        const int row0 = u.pm * BM + wr * 64 + fr, col0 = u.pn * BM + wc * 32 + 8 * fq;
        f32x4 bb[2][2];
#pragma unroll
        for (int bj = 0; bj < 2; ++bj) { bb[bj][0] = *(const f32x4*)(bias + col0 + bj * HALF); bb[bj][1] = *(const f32x4*)(bias + col0 + bj * HALF + 4); }
#pragma unroll
        for (int ai = 0; ai < 2; ++ai) {
            u32x4 yv[4][2];
#pragma unroll
            for (int m = 0; m < 4; ++m)
#pragma unroll
                for (int bj = 0; bj < 2; ++bj) yv[m][bj] = *(const u32x4*)(Y + (size_t)(row0 + ai * HALF + m * 16) * ldy + col0 + bj * HALF);
            __builtin_amdgcn_sched_barrier(0);
#pragma unroll
            for (int m = 0; m < 4; ++m) { const int row = row0 + ai * HALF + m * 16;
#pragma unroll
                for (int bj = 0; bj < 2; ++bj) { const int c = col0 + bj * HALF;
                    float y[8]; unpack8(yv[m][bj], y);
                    const f32x4 v0 = acc[ai][bj][m][0] + bb[bj][0], v1 = acc[ai][bj][m][1] + bb[bj][1];
                    float o[8];
#pragma unroll
                    for (int j = 0; j < 4; ++j) { o[j] = y[j] * sigmoidf_(v0[j]); o[4 + j] = y[4 + j] * sigmoidf_(v1[j]); }
                    *(u32x4*)(O + (size_t)row * ldo + ocol0 + c) = pack8(o); } }
            __builtin_amdgcn_sched_barrier(0);
        }
    }
};
struct EpiMoeUp {
    static constexpr bool PERM = true;
    bf16_t* H; int ldh; const float* gatew; int ehalf;
    __device__ __forceinline__ void operator()(const f32x4 (&acc)[2][2][4][2], const Unit& u, int wr, int wc, int fr, int fq) const {
        const int row0 = u.pm * BM + wr * 64 + fr, col0 = u.pn * HALF + wc * 32 + 8 * fq, e = ehalf * 8 + (u.pn >> 1);
#pragma unroll
        for (int ai = 0; ai < 2; ++ai)
#pragma unroll
            for (int m = 0; m < 4; ++m) { const int row = row0 + ai * HALF + m * 16;
                const float gw = gatew[(size_t)row * 16 + e];
                float o[8];
#pragma unroll
                for (int n = 0; n < 2; ++n)
#pragma unroll
                    for (int j = 0; j < 4; ++j) o[4 * n + j] = siluf_(acc[ai][0][m][n][j]) * acc[ai][1][m][n][j] * gw;
                *(u32x4*)(H + (size_t)row * ldh + col0) = pack8(o); }
    }
};

struct GUnit { int pn, g, rt, row0, nvalid; };
template <int NP> struct GroupOrder {
    int G, c, c0, c1, c2, c3, m1, m2, m3, m4;
    __device__ void init(int G_, int c_, const int* cntp) { G = G_; c = c_;
        c0 = __builtin_amdgcn_readfirstlane(cntp[0]); c1 = __builtin_amdgcn_readfirstlane(cntp[1]); c2 = __builtin_amdgcn_readfirstlane(cntp[2]); c3 = __builtin_amdgcn_readfirstlane(cntp[3]);
        m1 = (c0 + 255) >> 8; m2 = m1 + ((c1 + 255) >> 8); m3 = m2 + ((c2 + 255) >> 8); m4 = m3 + ((c3 + 255) >> 8); }
    __device__ bool next(int i, GUnit& u) const {
        const int L = i * G + c; if (L >= m4 * NP) return false;
        const int R = L / NP; u.pn = L % NP;
        const int b1 = (R >= m1) ? 1 : 0, b2 = (R >= m2) ? 1 : 0, b3 = (R >= m3) ? 1 : 0;
        const int g = b1 + b2 + b3, cg = b1 * m1 + b2 * (m2 - m1) + b3 * (m3 - m2), ng = c0 + b1 * (c1 - c0) + b2 * (c2 - c1) + b3 * (c3 - c2);
        u.g = g; u.rt = R - cg; u.row0 = R * 256; const int rem = ng - u.rt * 256; u.nvalid = rem < 256 ? rem : 256; return true;
    }
};
template <class Epi, int NP, int K, int LDA, int LDB, bool GATHER, class Bsel>
__device__ __forceinline__ void gemm_phase_g(int WV_, LAS unsigned char* lds, const bf16_t* Abase, const int* idx, const GroupOrder<NP>& S, const Bsel& bsel, const Epi& E) {
    const int tid = otid(), wid = __builtin_amdgcn_readfirstlane(tid >> 6), lane = tid & 63, wr = wid >> 2, wc = wid & 3, fr = lane & 15, fq = lane >> 4;
    constexpr int nt = K / BK;
    int Rs, Cs; stage_rc(tid * 16, Rs, Cs);
    unsigned voffB[2];
#pragma unroll
    for (int i = 0; i < 2; ++i) { const int R = Rs + 64 * i; const int Rb = Epi::PERM ? ((R & ~31) + perm32(R & 31)) : R; voffB[i] = (unsigned)(Rb * LDB + Cs) * 2u; }
    constexpr size_t kstep = (size_t)(BK * 2);
    constexpr size_t hstepB = (size_t)HALF * LDB * 2;
    const unsigned ldsw = (unsigned)wid * 1024u;
    const int aoff = lds_byte(wr * 64 + fr, fq * 8), boff = lds_byte(wc * 32 + fr, fq * 8);
#define PG8_SA(b, h) (((b) * 2 + (h)) * HTB)
#define PG8_SB(b, h) ((4 + (b) * 2 + (h)) * HTB)
#define PG8_STAGE(bufoff, gbase, voff) do { _Pragma("unroll") for (int _i = 0; _i < 2; ++_i) \
        __builtin_amdgcn_global_load_lds((const unsigned*)((const char*)(gbase) + (voff)[_i]), (LAS unsigned*)(lds + (bufoff) + ldsw + _i * 8192), 16, 0, 0); } while (0)
#define PG8_LDA(dst, b, h) do { _Pragma("unroll") for (int m = 0; m < 4; ++m) _Pragma("unroll") for (int k = 0; k < 2; ++k) dst[m][k] = *(const LAS bf16x8*)(lds + PG8_SA(b, h) + aoff + m * 2048 + k * 1024); } while (0)
#define PG8_LDB(dst, b, h) do { _Pragma("unroll") for (int n = 0; n < 2; ++n) _Pragma("unroll") for (int k = 0; k < 2; ++k) dst[n][k] = *(const LAS bf16x8*)(lds + PG8_SB(b, h) + boff + n * 2048 + k * 1024); } while (0)
#define PG8_MMA(ai, bj, At, Bt) do { __builtin_amdgcn_s_setprio(1); _Pragma("unroll") for (int m = 0; m < 4; ++m) _Pragma("unroll") for (int n = 0; n < 2; ++n) _Pragma("unroll") for (int k = 0; k < 2; ++k) \
        acc[ai][bj][m][n] = __builtin_amdgcn_mfma_f32_16x16x32_bf16(Bt[n][k], At[m][k], acc[ai][bj][m][n], 0, 0, 0); __builtin_amdgcn_s_setprio(0); } while (0)
#define PG8_WAIT_V(n) asm volatile("s_waitcnt vmcnt(" #n ")" ::: "memory")
#define PG8_WAIT_L(n) asm volatile("s_waitcnt lgkmcnt(" #n ")" ::: "memory")
#define PG8_BAR __builtin_amdgcn_s_barrier()
#define PG8_SCHED __builtin_amdgcn_sched_barrier(0)
#define PG8_AOFFS(dst, u) do { _Pragma("unroll") for (int _h = 0; _h < 2; ++_h) _Pragma("unroll") for (int _i = 0; _i < 2; ++_i) { const int _r = 128 * _h + Rs + 64 * _i; \
        if (GATHER) { const int _p = (u).rt * 256 + _r; const int _tok = (_r < (u).nvalid) ? idx[(u).g * T + _p] : 0; dst[_h][_i] = (unsigned)(_tok * LDA + Cs) * 2u; } \
        else dst[_h][_i] = (unsigned)(((u).row0 + _r) * LDA + Cs) * 2u; } } while (0)
    GUnit cur, nxt; int ui = 0;
    if (!S.next(0, cur)) return;
    f32x4 acc[2][2][4][2];
#pragma unroll
    for (int a = 0; a < 2; ++a)
#pragma unroll
        for (int b = 0; b < 2; ++b)
#pragma unroll
            for (int m = 0; m < 4; ++m)
#pragma unroll
                for (int n = 0; n < 2; ++n) acc[a][b][m][n] = (f32x4){0.f, 0.f, 0.f, 0.f};
    bf16x8 At[4][2], B0[2][2], B1[2][2];
    unsigned vo[2][2], nvo[2][2];
    PG8_AOFFS(vo, cur);
    const char* gA = (const char*)Abase; const char* cB = bsel(cur);
    PG8_STAGE(PG8_SB(0, 0), cB, voffB); PG8_STAGE(PG8_SA(0, 0), gA, vo[0]); PG8_STAGE(PG8_SB(0, 1), cB + hstepB, voffB); PG8_STAGE(PG8_SA(0, 1), gA, vo[1]);
    if (wr == 1) PG8_BAR;
    PG8_WAIT_V(4); PG8_BAR;
    PG8_STAGE(PG8_SB(1, 0), cB + kstep, voffB); PG8_STAGE(PG8_SA(1, 0), gA + kstep, vo[0]); PG8_STAGE(PG8_SB(1, 1), cB + hstepB + kstep, voffB);
    PG8_WAIT_V(6); PG8_BAR;
    for (;;) {
        const bool has_next = S.next(ui + 1, nxt);
        if (has_next) { PG8_AOFFS(nvo, nxt); } else {
#pragma unroll
            for (int _h = 0; _h < 2; ++_h)
#pragma unroll
                for (int _i = 0; _i < 2; ++_i) nvo[_h][_i] = vo[_h][_i]; }
        const char* nB = has_next ? bsel(nxt) : cB;
        for (int t = 0; t < nt; t += 2) {
            const bool last = (t == nt - 2);
            const char* a1 = gA + (size_t)(t + 1) * kstep;
            const char* a2 = last ? gA : gA + (size_t)(t + 2) * kstep; const char* b2 = last ? nB : cB + (size_t)(t + 2) * kstep;
            const char* a3 = a2 + kstep; const char* b3 = b2 + kstep;
            unsigned v0[2], v1[2];
            v0[0] = last ? nvo[0][0] : vo[0][0]; v0[1] = last ? nvo[0][1] : vo[0][1]; v1[0] = last ? nvo[1][0] : vo[1][0]; v1[1] = last ? nvo[1][1] : vo[1][1];
            PG8_LDB(B0, 0, 0); PG8_SCHED; PG8_LDA(At, 0, 0); PG8_STAGE(PG8_SA(1, 1), a1, vo[1]);
            PG8_WAIT_L(8); PG8_BAR; PG8_WAIT_L(0); PG8_MMA(0, 0, At, B0); PG8_BAR; PG8_SCHED;
            PG8_LDB(B1, 0, 1); PG8_STAGE(PG8_SB(0, 0), b2, voffB);
            PG8_BAR; PG8_WAIT_L(0); PG8_MMA(0, 1, At, B1); PG8_BAR;
            PG8_LDA(At, 0, 1); PG8_STAGE(PG8_SA(0, 0), a2, v0);
            PG8_BAR; PG8_WAIT_L(0); PG8_MMA(1, 0, At, B0); PG8_BAR; PG8_SCHED;
            PG8_STAGE(PG8_SB(0, 1), b2 + hstepB, voffB);
            PG8_WAIT_V(6); PG8_BAR; PG8_MMA(1, 1, At, B1); PG8_BAR;
            PG8_LDB(B0, 1, 0); PG8_SCHED; PG8_LDA(At, 1, 0); PG8_STAGE(PG8_SA(0, 1), a2, v1);
            PG8_WAIT_L(8); PG8_BAR; PG8_WAIT_L(0); PG8_MMA(0, 0, At, B0); PG8_BAR; PG8_SCHED;
            PG8_LDB(B1, 1, 1); PG8_STAGE(PG8_SB(1, 0), b3, voffB);
            PG8_BAR; PG8_WAIT_L(0); PG8_MMA(0, 1, At, B1); PG8_BAR;
            PG8_LDA(At, 1, 1); PG8_STAGE(PG8_SA(1, 0), a3, v0);
            PG8_BAR; PG8_WAIT_L(0); PG8_MMA(1, 0, At, B0); PG8_BAR; PG8_SCHED;
            PG8_STAGE(PG8_SB(1, 1), b3 + hstepB, voffB);
            PG8_WAIT_V(6); PG8_BAR; PG8_MMA(1, 1, At, B1); PG8_BAR;
        }
        E(acc, cur, wr, wc, fr, fq);
        if (!has_next) break;
#pragma unroll
        for (int a = 0; a < 2; ++a)
#pragma unroll
            for (int b = 0; b < 2; ++b)
#pragma unroll
                for (int m = 0; m < 4; ++m)
#pragma unroll
                    for (int n = 0; n < 2; ++n) acc[a][b][m][n] = (f32x4){0.f, 0.f, 0.f, 0.f};
        cur = nxt; cB = nB; ++ui;
#pragma unroll
        for (int _h = 0; _h < 2; ++_h)
#pragma unroll
            for (int _i = 0; _i < 2; ++_i) vo[_h][_i] = nvo[_h][_i];
    }
    PG8_WAIT_V(0);
    if (wr == 0) PG8_BAR;
    PG8_BAR;
#undef PG8_AOFFS
#undef PG8_SA
#undef PG8_SB
#undef PG8_STAGE
#undef PG8_LDA
#undef PG8_LDB
#undef PG8_MMA
#undef PG8_WAIT_V
#undef PG8_WAIT_L
#undef PG8_BAR
#undef PG8_SCHED
}
struct MUnit { int kind, pn, g, rt, row0, nvalid; };
struct MoeOrder {
    int G, c, c0, c1, c2, c3, m1, m2, m3, m4, ua, nup, da, ntot;
    __device__ void init(int G_, int c_, const int* cntp) { G = G_; c = c_;
        c0 = __builtin_amdgcn_readfirstlane(cntp[0]); c1 = __builtin_amdgcn_readfirstlane(cntp[1]); c2 = __builtin_amdgcn_readfirstlane(cntp[2]); c3 = __builtin_amdgcn_readfirstlane(cntp[3]);
        m1 = (c0 + 255) >> 8; m2 = m1 + ((c1 + 255) >> 8); m3 = m2 + ((c2 + 255) >> 8); m4 = m3 + ((c3 + 255) >> 8); ua = 0; nup = 0; da = 0; ntot = 0; }
    __device__ void range(int ua_, int ub_, int da_, int db_) { ua = ua_; nup = (ub_ - ua_) * 8; da = da_; ntot = nup + (db_ - da_) * 4; }
    __device__ bool next(int i, MUnit& u) const {
        int L = i * G + c; if (L >= ntot) return false;
        const int kind = (L >= nup) ? 1 : 0; L -= kind * nup;
        const int R = kind ? da + (L >> 2) : ua + (L >> 3); u.kind = kind; u.pn = kind ? (L & 3) : (L & 7);
        const int b1 = (R >= m1) ? 1 : 0, b2 = (R >= m2) ? 1 : 0, b3 = (R >= m3) ? 1 : 0;
        const int g = b1 + b2 + b3, cg = b1 * m1 + b2 * (m2 - m1) + b3 * (m3 - m2), ng = c0 + b1 * (c1 - c0) + b2 * (c2 - c1) + b3 * (c3 - c2);
        u.g = g; u.rt = R - cg; u.row0 = R * 256; const int rem = ng - u.rt * 256; u.nvalid = rem < 256 ? rem : 256; return true;
    }
};
template <class EpiU, class EpiD, int K, int LDA, int LDB, class Bsel>
__device__ __forceinline__ void gemm_phase_moe(int WV_, LAS unsigned char* lds, const bf16_t* Aup, const bf16_t* Adn, const int* idx, const MoeOrder& S, const Bsel& bsel, const EpiU& EU, const EpiD& ED) {
    const int tid = otid(), wid = __builtin_amdgcn_readfirstlane(tid >> 6), lane = tid & 63, wr = wid >> 2, wc = wid & 3, fr = lane & 15, fq = lane >> 4;
    constexpr int nt = K / BK;
    unsigned voffB[2];
#pragma unroll
    for (int i = 0; i < 2; ++i) { int Rs, Cs; stage_rc(tid * 16, Rs, Cs); const int R = Rs + 64 * i; const int Rb = (R & ~31) + perm32(R & 31); voffB[i] = (unsigned)(Rb * LDB + Cs) * 2u; }
    constexpr size_t kstep = (size_t)(BK * 2);
    constexpr size_t hstepB = (size_t)HALF * LDB * 2;
    const unsigned ldsw = (unsigned)wid * 1024u;
    const int aoff = lds_byte(wr * 64 + fr, fq * 8), boff = lds_byte(wc * 32 + fr, fq * 8);
#define PG8_SA(b, h) (((b) * 2 + (h)) * HTB)
#define PG8_SB(b, h) ((4 + (b) * 2 + (h)) * HTB)
#define PG8_STAGE(bufoff, gbase, voff) do { _Pragma("unroll") for (int _i = 0; _i < 2; ++_i) \
        __builtin_amdgcn_global_load_lds((const unsigned*)((const char*)(gbase) + (voff)[_i]), (LAS unsigned*)(lds + (bufoff) + ldsw + _i * 8192), 16, 0, 0); } while (0)
#define PG8_LDA(dst, b, h) do { _Pragma("unroll") for (int m = 0; m < 4; ++m) _Pragma("unroll") for (int k = 0; k < 2; ++k) dst[m][k] = *(const LAS bf16x8*)(lds + PG8_SA(b, h) + aoff + m * 2048 + k * 1024); } while (0)
#define PG8_LDB(dst, b, h) do { _Pragma("unroll") for (int n = 0; n < 2; ++n) _Pragma("unroll") for (int k = 0; k < 2; ++k) dst[n][k] = *(const LAS bf16x8*)(lds + PG8_SB(b, h) + boff + n * 2048 + k * 1024); } while (0)
#define PG8_MMA(ai, bj, At, Bt) do { __builtin_amdgcn_s_setprio(1); _Pragma("unroll") for (int m = 0; m < 4; ++m) _Pragma("unroll") for (int n = 0; n < 2; ++n) _Pragma("unroll") for (int k = 0; k < 2; ++k) \
        acc[ai][bj][m][n] = __builtin_amdgcn_mfma_f32_16x16x32_bf16(Bt[n][k], At[m][k], acc[ai][bj][m][n], 0, 0, 0); __builtin_amdgcn_s_setprio(0); } while (0)
#define PG8_WAIT_V(n) asm volatile("s_waitcnt vmcnt(" #n ")" ::: "memory")
#define PG8_WAIT_L(n) asm volatile("s_waitcnt lgkmcnt(" #n ")" ::: "memory")
#define PG8_BAR __builtin_amdgcn_s_barrier()
#define PG8_SCHED __builtin_amdgcn_sched_barrier(0)
#define PG8_AOFFS(dst, u) do { int Rs, Cs; stage_rc(otid() * 16, Rs, Cs); _Pragma("unroll") for (int _h = 0; _h < 2; ++_h) _Pragma("unroll") for (int _i = 0; _i < 2; ++_i) { const int _r = 128 * _h + Rs + 64 * _i; \
        if ((u).kind == 0) { const int _p = (u).rt * 256 + _r; const int _tok = (_r < (u).nvalid) ? idx[(u).g * T + _p] : 0; dst[_h][_i] = (unsigned)(_tok * LDA + Cs) * 2u; } \
        else dst[_h][_i] = (unsigned)(((u).row0 + _r) * LDA + Cs) * 2u; } } while (0)
    MUnit cur, nxt; int ui = 0;
    if (!S.next(0, cur)) return;
    f32x4 acc[2][2][4][2];
#pragma unroll
    for (int a = 0; a < 2; ++a)
#pragma unroll
        for (int b = 0; b < 2; ++b)
#pragma unroll
            for (int m = 0; m < 4; ++m)
#pragma unroll
                for (int n = 0; n < 2; ++n) acc[a][b][m][n] = (f32x4){0.f, 0.f, 0.f, 0.f};
    bf16x8 At[4][2], B0[2][2], B1[2][2];
    unsigned vo[2][2], nvo[2][2];
    PG8_AOFFS(vo, cur);
    const char* gA = (const char*)(cur.kind ? Adn : Aup); const char* cB = bsel(cur);
    PG8_STAGE(PG8_SB(0, 0), cB, voffB); PG8_STAGE(PG8_SA(0, 0), gA, vo[0]); PG8_STAGE(PG8_SB(0, 1), cB + hstepB, voffB); PG8_STAGE(PG8_SA(0, 1), gA, vo[1]);
    if (wr == 1) PG8_BAR;
    PG8_WAIT_V(4); PG8_BAR;
    PG8_STAGE(PG8_SB(1, 0), cB + kstep, voffB); PG8_STAGE(PG8_SA(1, 0), gA + kstep, vo[0]); PG8_STAGE(PG8_SB(1, 1), cB + hstepB + kstep, voffB);
    PG8_WAIT_V(6); PG8_BAR;
    for (;;) {
        const bool has_next = S.next(ui + 1, nxt);
        if (has_next) { PG8_AOFFS(nvo, nxt); } else {
#pragma unroll
            for (int _h = 0; _h < 2; ++_h)
#pragma unroll
                for (int _i = 0; _i < 2; ++_i) nvo[_h][_i] = vo[_h][_i]; }
        const char* nB = has_next ? bsel(nxt) : cB; const char* nA = has_next ? (const char*)(nxt.kind ? Adn : Aup) : gA;
        for (int t = 0; t < nt; t += 2) {
            const bool last = (t == nt - 2);
            const char* a1 = gA + (size_t)(t + 1) * kstep;
            const char* a2 = last ? nA : gA + (size_t)(t + 2) * kstep; const char* b2 = last ? nB : cB + (size_t)(t + 2) * kstep;
            const char* a3 = a2 + kstep; const char* b3 = b2 + kstep;
            unsigned v0[2], v1[2];
            v0[0] = last ? nvo[0][0] : vo[0][0]; v0[1] = last ? nvo[0][1] : vo[0][1]; v1[0] = last ? nvo[1][0] : vo[1][0]; v1[1] = last ? nvo[1][1] : vo[1][1];
            PG8_LDB(B0, 0, 0); PG8_SCHED; PG8_LDA(At, 0, 0); PG8_STAGE(PG8_SA(1, 1), a1, vo[1]);
            PG8_WAIT_L(8); PG8_BAR; PG8_WAIT_L(0); PG8_MMA(0, 0, At, B0); PG8_BAR; PG8_SCHED;
            PG8_LDB(B1, 0, 1); PG8_STAGE(PG8_SB(0, 0), b2, voffB);
            PG8_BAR; PG8_WAIT_L(0); PG8_MMA(0, 1, At, B1); PG8_BAR;
            PG8_LDA(At, 0, 1); PG8_STAGE(PG8_SA(0, 0), a2, v0);
            PG8_BAR; PG8_WAIT_L(0); PG8_MMA(1, 0, At, B0); PG8_BAR; PG8_SCHED;
            PG8_STAGE(PG8_SB(0, 1), b2 + hstepB, voffB);
            PG8_WAIT_V(6); PG8_BAR; PG8_MMA(1, 1, At, B1); PG8_BAR;
            PG8_LDB(B0, 1, 0); PG8_SCHED; PG8_LDA(At, 1, 0); PG8_STAGE(PG8_SA(0, 1), a2, v1);
            PG8_WAIT_L(8); PG8_BAR; PG8_WAIT_L(0); PG8_MMA(0, 0, At, B0); PG8_BAR; PG8_SCHED;
            PG8_LDB(B1, 1, 1); PG8_STAGE(PG8_SB(1, 0), b3, voffB);
            PG8_BAR; PG8_WAIT_L(0); PG8_MMA(0, 1, At, B1); PG8_BAR;
            PG8_LDA(At, 1, 1); PG8_STAGE(PG8_SA(1, 0), a3, v0);
            PG8_BAR; PG8_WAIT_L(0); PG8_MMA(1, 0, At, B0); PG8_BAR; PG8_SCHED;
            PG8_STAGE(PG8_SB(1, 1), b3 + hstepB, voffB);
            PG8_WAIT_V(6); PG8_BAR; PG8_MMA(1, 1, At, B1); PG8_BAR;
        }
        if (cur.kind == 0) EU(acc, cur, wr, wc, fr, fq); else ED(acc, cur, wr, wc, fr, fq);
        if (!has_next) break;
#pragma unroll
        for (int a = 0; a < 2; ++a)
#pragma unroll
            for (int b = 0; b < 2; ++b)
#pragma unroll
                for (int m = 0; m < 4; ++m)
#pragma unroll
                    for (int n = 0; n < 2; ++n) acc[a][b][m][n] = (f32x4){0.f, 0.f, 0.f, 0.f};
        cur = nxt; cB = nB; gA = nA; ++ui;
#pragma unroll
        for (int _h = 0; _h < 2; ++_h)
#pragma unroll
            for (int _i = 0; _i < 2; ++_i) vo[_h][_i] = nvo[_h][_i];
    }
    PG8_WAIT_V(0);
    if (wr == 0) PG8_BAR;
    PG8_BAR;
#undef PG8_AOFFS
#undef PG8_SA
#undef PG8_SB
#undef PG8_STAGE
#undef PG8_LDA
#undef PG8_LDB
#undef PG8_MMA
#undef PG8_WAIT_V
#undef PG8_WAIT_L
#undef PG8_BAR
#undef PG8_SCHED
}
struct EpiMoeUpG {
    static constexpr bool PERM = true;
    bf16_t* H; const float* gs; const int* idx; const float* rstd;
    template <class U> __device__ __forceinline__ void operator()(const f32x4 (&acc)[2][2][4][2], const U& u, int wr, int wc, int fr, int fq) const {
        const int r0 = wr * 64 + fr, col0 = u.pn * HALF + wc * 32 + 8 * fq, el = u.pn >> 1;
#pragma unroll
        for (int ai = 0; ai < 2; ++ai)
#pragma unroll
            for (int m = 0; m < 4; ++m) { const int r = r0 + ai * HALF + m * 16; const bool ok = r < u.nvalid; const size_t slot = (size_t)u.g * T + u.rt * 256 + r;
                const float gw = ok ? gs[slot * 4 + el] : 0.f, rs = ok ? rstd[slot] : 0.f;
                float o[8];
#pragma unroll
                for (int n = 0; n < 2; ++n)
#pragma unroll
                    for (int j = 0; j < 4; ++j) o[4 * n + j] = siluf_(acc[ai][0][m][n][j] * rs) * (acc[ai][1][m][n][j] * rs) * gw;
                *(u32x4*)(H + (size_t)(u.row0 + r) * 1024 + col0) = pack8(o); }
    }
};
struct EpiMoeDownG {
    static constexpr bool PERM = true;
    float* OUT; const int* idx; bf16_t* HB; float* ss;
    template <class U> __device__ __forceinline__ void operator()(const f32x4 (&acc)[2][2][4][2], const U& u, int wr, int wc, int fr, int fq) const {
        const int r0 = wr * 64 + fr, col0 = u.pn * BM + wc * 32 + 8 * fq;
#pragma unroll
        for (int ai = 0; ai < 2; ++ai)
#pragma unroll
            for (int m = 0; m < 4; ++m) { const int r = r0 + ai * HALF + m * 16; const bool ok = r < u.nvalid; float sq = 0.f; int tok = 0;
                if (ok) { tok = idx[u.g * T + u.rt * 256 + r];
#pragma unroll
                    for (int bj = 0; bj < 2; ++bj) { bf16_t* ph = HB + (size_t)tok * D + col0 + bj * HALF; float o[8]; unpack8(*(const u32x4*)ph, o);
#pragma unroll
                        for (int j = 0; j < 4; ++j) { o[j] += acc[ai][bj][m][0][j]; o[4 + j] += acc[ai][bj][m][1][j]; }
#pragma unroll
                        for (int j = 0; j < 8; ++j) sq += o[j] * o[j];
                        *(u32x4*)ph = pack8(o);
                        if (OUT) { float* p = OUT + (size_t)tok * D + col0 + bj * HALF; *(f32x4*)p = (f32x4){o[0], o[1], o[2], o[3]}; *(f32x4*)(p + 4) = (f32x4){o[4], o[5], o[6], o[7]}; } } }
                sq = sum_rows(sq);
                if (ok && fq == 0 && ss) ss[(size_t)tok * 16 + u.pn * 4 + wc] = sq; }
    }
};
struct MUnit2 { int kind, pn, q, rt, row0, nvalid;
    __device__ __forceinline__ int g() const { return q / 6; }
    __device__ __forceinline__ int elo() const { const int p = q - 6 * (q / 6); return ((p >= 3) ? 1 : 0) + ((p >= 5) ? 1 : 0); }
    __device__ __forceinline__ int ehi() const { const int p = q - 6 * (q / 6); return p + 1 - ((p >= 3) ? 2 : 0) - ((p >= 5) ? 1 : 0); } };
constexpr int MOE_TAB = 131072;
struct MoeOrder2 {
    int G, c, mtot, ua, nup, da, ntot; const LAS int* tab;
    __device__ __forceinline__ void init(int G_, int c_, const int* cntp, int lane, LAS unsigned char* lds) { G = G_; c = ((G_ & 7) == 0) ? (c_ & 7) * (G_ >> 3) + (c_ >> 3) : c_;
        LAS int* tw = (LAS int*)(lds + MOE_TAB); tab = tw;
        const int cntv = (lane < 24) ? cntp[lane] : 0; int pmv = 0x7fffffff; int s = 0;
#pragma unroll
        for (int j = 0; j < 24; ++j) { const int cj = __builtin_amdgcn_readlane(cntv, j); if (lane == j) pmv = s; s += (cj + 255) >> 8; }
        if (lane < 32) { tw[lane] = pmv; tw[32 + lane] = cntv; }
        mtot = s; ua = 0; nup = 0; da = 0; ntot = 0; }
    __device__ __forceinline__ void range(int ua_, int ub_, int da_, int db_) { ua = ua_; nup = (ub_ - ua_) * 4; da = da_; ntot = nup + (db_ - da_) * 4; }
    __device__ __forceinline__ bool next(int i, MUnit2& u) const {
        int Lr = i * G + ((i & 1) ? G - 1 - c : c); if (Lr >= ntot) return false;
        const int kind = (Lr >= nup) ? 1 : 0; Lr -= kind * nup;
        const int R = ua + kind * (da - ua) + (Lr >> 2); u.kind = kind; u.pn = Lr & 3;
        int qv = -1;
#pragma unroll
        for (int j = 0; j < 24; ++j) qv += (tab[j] <= R) ? 1 : 0;
        const int q = __builtin_amdgcn_readfirstlane(qv);
        const int cg = __builtin_amdgcn_readfirstlane(tab[q]), ng = __builtin_amdgcn_readfirstlane(tab[32 + q]);
        u.q = q; u.rt = R - cg; u.row0 = R * 256; const int rem = ng - u.rt * 256; u.nvalid = rem < 256 ? rem : 256; return true;
    }
};
template <class EpiU, class EpiD, class Bsel>
__device__ __forceinline__ void gemm_phase_moe2(int WV_, LAS unsigned char* lds, const bf16_t* Aup, const bf16_t* Adn, const int* idx, const MoeOrder2& S, const Bsel& bsel, const EpiU& EU, const EpiD& ED) {
    const int tid = otid(), wid = __builtin_amdgcn_readfirstlane(tid >> 6), lane = tid & 63, wr = wid >> 2, wc = wid & 3, fr = lane & 15, fq = lane >> 4;
    constexpr int LDB = 1024;
    unsigned voffB[2];
#pragma unroll
    for (int i = 0; i < 2; ++i) { int Rs, Cs; stage_rc(tid * 16, Rs, Cs); const int R = Rs + 64 * i; const int Rb = (R & ~31) + perm32(R & 31); voffB[i] = (unsigned)(Rb * LDB + Cs) * 2u; }
    constexpr size_t kstep = (size_t)(BK * 2);
    constexpr size_t hstepB = (size_t)HALF * LDB * 2;
    const unsigned ldsw = (unsigned)wid * 1024u;
    const int aoff = lds_byte(wr * 64 + fr, fq * 8), boff = lds_byte(wc * 32 + fr, fq * 8);
#define PG8_SA(b, h) (((b) * 2 + (h)) * HTB)
#define PG8_SB(b, h) ((4 + (b) * 2 + (h)) * HTB)
#define PG8_STAGE(bufoff, gbase, voff) do { _Pragma("unroll") for (int _i = 0; _i < 2; ++_i) \
        __builtin_amdgcn_global_load_lds((const unsigned*)((const char*)(gbase) + (voff)[_i]), (LAS unsigned*)(lds + (bufoff) + ldsw + _i * 8192), 16, 0, 0); } while (0)
#define PG8_LDA(dst, b, h) do { _Pragma("unroll") for (int m = 0; m < 4; ++m) _Pragma("unroll") for (int k = 0; k < 2; ++k) dst[m][k] = *(const LAS bf16x8*)(lds + PG8_SA(b, h) + aoff + m * 2048 + k * 1024); } while (0)
#define PG8_LDB(dst, b, h) do { _Pragma("unroll") for (int n = 0; n < 2; ++n) _Pragma("unroll") for (int k = 0; k < 2; ++k) dst[n][k] = *(const LAS bf16x8*)(lds + PG8_SB(b, h) + boff + n * 2048 + k * 1024); } while (0)
#define PG8_MMA(ai, bj, At, Bt) do { __builtin_amdgcn_s_setprio(1); _Pragma("unroll") for (int m = 0; m < 4; ++m) _Pragma("unroll") for (int n = 0; n < 2; ++n) _Pragma("unroll") for (int k = 0; k < 2; ++k) \
        acc[ai][bj][m][n] = __builtin_amdgcn_mfma_f32_16x16x32_bf16(Bt[n][k], At[m][k], acc[ai][bj][m][n], 0, 0, 0); __builtin_amdgcn_s_setprio(0); } while (0)
#define PG8_WAIT_V(n) asm volatile("s_waitcnt vmcnt(" #n ")" ::: "memory")
#define PG8_WAIT_L(n) asm volatile("s_waitcnt lgkmcnt(" #n ")" ::: "memory")
#define PG8_BAR __builtin_amdgcn_s_barrier()
#define PG8_SCHED __builtin_amdgcn_sched_barrier(0)
#define PG8_AOFFS(dst, u) do { int Rs, Cs; stage_rc(otid() * 16, Rs, Cs); _Pragma("unroll") for (int _h = 0; _h < 2; ++_h) _Pragma("unroll") for (int _i = 0; _i < 2; ++_i) { const int _r = 128 * _h + Rs + 64 * _i; \
        if ((u).kind == 0) { const int _p = (u).rt * 256 + _r; const int _tok = (_r < (u).nvalid) ? idx[(u).q * T + _p] : 0; dst[_h][_i] = (unsigned)(_tok * 1024 + Cs) * 2u; } \
        else dst[_h][_i] = (unsigned)(((u).row0 + _r) * 512 + Cs) * 2u; } } while (0)
    MUnit2 cur, nxt; int ui = 0;
    if (!S.next(0, cur)) return;
    f32x4 acc[2][2][4][2];
#pragma unroll
    for (int a = 0; a < 2; ++a)
#pragma unroll
        for (int b = 0; b < 2; ++b)
#pragma unroll
            for (int m = 0; m < 4; ++m)
#pragma unroll
                for (int n = 0; n < 2; ++n) acc[a][b][m][n] = (f32x4){0.f, 0.f, 0.f, 0.f};
    bf16x8 At[4][2], B0[2][2], B1[2][2];
    unsigned vo[2][2], nvo[2][2];
    PG8_AOFFS(vo, cur);
    const char* gA = (const char*)(cur.kind ? Adn : Aup); const char* cB = bsel(cur);
    PG8_STAGE(PG8_SB(0, 0), cB, voffB); PG8_STAGE(PG8_SA(0, 0), gA, vo[0]); PG8_STAGE(PG8_SB(0, 1), cB + hstepB, voffB); PG8_STAGE(PG8_SA(0, 1), gA, vo[1]);
    if (wr == 1) PG8_BAR;
    PG8_WAIT_V(4); PG8_BAR;
    PG8_STAGE(PG8_SB(1, 0), cB + kstep, voffB); PG8_STAGE(PG8_SA(1, 0), gA + kstep, vo[0]); PG8_STAGE(PG8_SB(1, 1), cB + hstepB + kstep, voffB);
    PG8_WAIT_V(6); PG8_BAR;
    for (;;) {
        const bool has_next = S.next(ui + 1, nxt);
        if (has_next) { PG8_AOFFS(nvo, nxt); } else {
#pragma unroll
            for (int _h = 0; _h < 2; ++_h)
#pragma unroll
                for (int _i = 0; _i < 2; ++_i) nvo[_h][_i] = vo[_h][_i]; }
        const char* nB = has_next ? bsel(nxt) : cB; const char* nA = has_next ? (const char*)(nxt.kind ? Adn : Aup) : gA;
        const int ntc = __builtin_amdgcn_readfirstlane(16 - 8 * cur.kind);
        const size_t jmp = (size_t)(cur.kind * (cur.ehi() - cur.elo() - 1) * 512);
        for (int t = 0; t < ntc; t += 2) {
            const bool last = (t == ntc - 2);
            const char* a1 = gA + (size_t)(t + 1) * kstep;
            const char* a2 = last ? nA : gA + (size_t)(t + 2) * kstep; const char* b2 = last ? nB : cB + (size_t)(t + 2) * kstep + ((t + 2 >= 4) ? jmp : (size_t)0);
            const char* a3 = a2 + kstep; const char* b3 = b2 + kstep;
            unsigned v0[2], v1[2];
            v0[0] = last ? nvo[0][0] : vo[0][0]; v0[1] = last ? nvo[0][1] : vo[0][1]; v1[0] = last ? nvo[1][0] : vo[1][0]; v1[1] = last ? nvo[1][1] : vo[1][1];
            PG8_LDB(B0, 0, 0); PG8_SCHED; PG8_LDA(At, 0, 0); PG8_STAGE(PG8_SA(1, 1), a1, vo[1]);
            PG8_WAIT_L(8); PG8_BAR; PG8_WAIT_L(0); PG8_MMA(0, 0, At, B0); PG8_BAR; PG8_SCHED;
            PG8_LDB(B1, 0, 1); PG8_STAGE(PG8_SB(0, 0), b2, voffB);
            PG8_BAR; PG8_WAIT_L(0); PG8_MMA(0, 1, At, B1); PG8_BAR;
            PG8_LDA(At, 0, 1); PG8_STAGE(PG8_SA(0, 0), a2, v0);
            PG8_BAR; PG8_WAIT_L(0); PG8_MMA(1, 0, At, B0); PG8_BAR; PG8_SCHED;
            PG8_STAGE(PG8_SB(0, 1), b2 + hstepB, voffB);
            PG8_WAIT_V(6); PG8_BAR; PG8_MMA(1, 1, At, B1); PG8_BAR;
            PG8_LDB(B0, 1, 0); PG8_SCHED; PG8_LDA(At, 1, 0); PG8_STAGE(PG8_SA(0, 1), a2, v1);
            PG8_WAIT_L(8); PG8_BAR; PG8_WAIT_L(0); PG8_MMA(0, 0, At, B0); PG8_BAR; PG8_SCHED;
            PG8_LDB(B1, 1, 1); PG8_STAGE(PG8_SB(1, 0), b3, voffB);
            PG8_BAR; PG8_WAIT_L(0); PG8_MMA(0, 1, At, B1); PG8_BAR;
            PG8_LDA(At, 1, 1); PG8_STAGE(PG8_SA(1, 0), a3, v0);
            PG8_BAR; PG8_WAIT_L(0); PG8_MMA(1, 0, At, B0); PG8_BAR; PG8_SCHED;
            PG8_STAGE(PG8_SB(1, 1), b3 + hstepB, voffB);
            PG8_WAIT_V(6); PG8_BAR; PG8_MMA(1, 1, At, B1); PG8_BAR;
        }
        if (cur.kind == 0) EU(acc, cur, wr, wc, fr, fq); else ED(acc, cur, wr, wc, fr, fq);
        if (!has_next) break;
#pragma unroll
        for (int a = 0; a < 2; ++a)
#pragma unroll
            for (int b = 0; b < 2; ++b)
#pragma unroll
                for (int m = 0; m < 4; ++m)
#pragma unroll
                    for (int n = 0; n < 2; ++n) acc[a][b][m][n] = (f32x4){0.f, 0.f, 0.f, 0.f};
        cur = nxt; cB = nB; gA = nA; ++ui;
#pragma unroll
        for (int _h = 0; _h < 2; ++_h)
#pragma unroll
            for (int _i = 0; _i < 2; ++_i) vo[_h][_i] = nvo[_h][_i];
    }
    PG8_WAIT_V(0);
    if (wr == 0) PG8_BAR;
    PG8_BAR;
#undef PG8_AOFFS
#undef PG8_SA
#undef PG8_SB
#undef PG8_STAGE
#undef PG8_LDA
#undef PG8_LDB
#undef PG8_MMA
#undef PG8_WAIT_V
#undef PG8_WAIT_L
#undef PG8_BAR
#undef PG8_SCHED
}
struct EpiMoeUpP {
    static constexpr bool PERM = true;
    bf16_t* H; const float* gs; const float* rstd;
    template <class U> __device__ __forceinline__ void operator()(const f32x4 (&acc)[2][2][4][2], const U& u, int wr, int wc, int fr, int fq) const {
        const int r0 = wr * 64 + fr, col0 = u.pn * HALF + wc * 32 + 8 * fq, el = u.pn >> 1;
        float gwv[2][4], rsv[2][4];
#pragma unroll
        for (int ai = 0; ai < 2; ++ai)
#pragma unroll
            for (int m = 0; m < 4; ++m) { const int r = r0 + ai * HALF + m * 16; const bool ok = r < u.nvalid; const size_t slot = (size_t)u.q * T + u.rt * 256 + r;
                gwv[ai][m] = ok ? gs[slot * 2 + el] : 0.f; rsv[ai][m] = ok ? rstd[slot] : 0.f; }
        __builtin_amdgcn_sched_barrier(0);
#pragma unroll
        for (int ai = 0; ai < 2; ++ai)
#pragma unroll
            for (int m = 0; m < 4; ++m) { const int r = r0 + ai * HALF + m * 16; const float gw = gwv[ai][m], rs = rsv[ai][m];
                float o[8];
#pragma unroll
                for (int n = 0; n < 2; ++n)
#pragma unroll
                    for (int j = 0; j < 4; ++j) o[4 * n + j] = siluf_(acc[ai][0][m][n][j] * rs) * (acc[ai][1][m][n][j] * rs) * gw;
                *(u32x4*)(H + (size_t)(u.row0 + r) * 512 + col0) = pack8(o); }
    }
};
struct EpiMoeDownP {
    static constexpr bool PERM = true;
    float* OUT; const int* idx; bf16_t* HB; float* ss;
    template <class U> __device__ __forceinline__ void operator()(const f32x4 (&acc)[2][2][4][2], const U& u, int wr, int wc, int fr, int fq) const {
        const int r0 = wr * 64 + fr, col0 = u.pn * BM + wc * 32 + 8 * fq;
        int tok[2][4];
#pragma unroll
        for (int ai = 0; ai < 2; ++ai)
#pragma unroll
            for (int m = 0; m < 4; ++m) { const int r = r0 + ai * HALF + m * 16; tok[ai][m] = (r < u.nvalid) ? idx[u.q * T + u.rt * 256 + r] : -1; }
#pragma unroll
        for (int ai = 0; ai < 2; ++ai) {
            u32x4 old[4][2];
#pragma unroll
            for (int m = 0; m < 4; ++m)
#pragma unroll
                for (int bj = 0; bj < 2; ++bj) old[m][bj] = *(const u32x4*)(HB + (size_t)(tok[ai][m] < 0 ? 0 : tok[ai][m]) * D + col0 + bj * HALF);
            __builtin_amdgcn_sched_barrier(0);
#pragma unroll
            for (int m = 0; m < 4; ++m) { const bool ok = tok[ai][m] >= 0; float sq = 0.f;
                if (ok) {
#pragma unroll
                    for (int bj = 0; bj < 2; ++bj) { bf16_t* ph = HB + (size_t)tok[ai][m] * D + col0 + bj * HALF; float o[8]; unpack8(old[m][bj], o);
#pragma unroll
                        for (int j = 0; j < 4; ++j) { o[j] += acc[ai][bj][m][0][j]; o[4 + j] += acc[ai][bj][m][1][j]; }
#pragma unroll
                        for (int j = 0; j < 8; ++j) sq += o[j] * o[j];
                        if (!OUT) *(u32x4*)ph = pack8(o);
                        if (OUT) { float* p = OUT + (size_t)tok[ai][m] * D + col0 + bj * HALF; *(f32x4*)p = (f32x4){o[0], o[1], o[2], o[3]}; *(f32x4*)(p + 4) = (f32x4){o[4], o[5], o[6], o[7]}; } } }
                sq = sum_rows(sq);
                if (ok && fq == 0 && ss) ss[(size_t)tok[ai][m] * 16 + u.pn * 4 + wc] = sq; }
            __builtin_amdgcn_sched_barrier(0);
        }
    }
};
}

struct Args { const float* in[41]; float* out; unsigned char* ws; int lo, hi; };
constexpr int LDS_SCRATCH = 153600, LDS_BYTES = LDS_SCRATCH + 256;
__device__ __forceinline__ int arg_lohi(const Args& a, int i) { i = __builtin_amdgcn_readfirstlane(i); asm volatile("" : "+s"(i)); return __builtin_amdgcn_readfirstlane((&a.lo)[i]); }
__device__ __forceinline__ const float* inp(const Args& a, int i) { i = __builtin_amdgcn_readfirstlane(i); asm volatile("" : "+s"(i)); return a.in[i]; }

enum { I_X = 0, I_MEM, I_MEMG, I_WMKV, I_NMIX, I_NXA, I_NFFN, I_XWQ, I_XWO, I_XQG, I_XKG, I_WGRP, I_BGRP, I_WEXP, I_BEXP, I_W1, I_W3, I_W2,
       I_EVIN, I_EVOUT, I_GMWS, I_GMBS, I_GMLN, I_LAMRE, I_LAMIM, I_BRE, I_BIM, I_CRE, I_CIM, I_S5D, I_LOGSTEP, I_WGLU, I_BGLU,
       I_ODIN, I_ODOUT, I_CONVW, I_CONVB, I_BIF, I_HNG, I_MBQG, I_MBKG };

struct XI { const float* W; bf16_t* WT; const float* gk; int ldw, ldt, k0, n0, drow0; };
__device__ __forceinline__ void xi_load(const XI& x, int lane, float (&v_)[32]) {
#pragma unroll
    for (int i = 0; i < 32; ++i) { const int kk = 2 * i + (lane >> 5); v_[i] = x.W[(size_t)(x.k0 + kk) * x.ldw + x.n0 + (lane & 31)]; }
}
__device__ __forceinline__ void xi_finish(const XI& x, float (&v_)[32], float* scr, int lane) {
    if (x.gk) {
#pragma unroll
        for (int i = 0; i < 32; ++i) v_[i] *= x.gk[x.k0 + 2 * i + (lane >> 5)]; }
#pragma unroll
    for (int i = 0; i < 32; ++i) { const int kk = 2 * i + (lane >> 5); scr[kk * 33 + (lane & 31)] = v_[i]; }
    asm volatile("s_waitcnt lgkmcnt(0)" ::: "memory");
    const int c = lane & 7;
#pragma unroll
    for (int j = 0; j < 4; ++j) { const int n = (lane >> 3) + 8 * j; const float* sp = scr + (8 * c) * 33 + n;
        u32x4 o; o.x = pk2(sp[0 * 33], sp[1 * 33]); o.y = pk2(sp[2 * 33], sp[3 * 33]); o.z = pk2(sp[4 * 33], sp[5 * 33]); o.w = pk2(sp[6 * 33], sp[7 * 33]);
        *(u32x4*)(x.WT + (size_t)(x.drow0 + n) * x.ldt + x.k0 + 8 * c) = o; }
    asm volatile("s_waitcnt lgkmcnt(0)" ::: "memory");
}
__device__ __forceinline__ XI xi_decode(const Args& a, unsigned char* ws, int it) {
    constexpr int N_MKV = 16 * 64, N_SQ = 16 * 32, N_EXP = 16 * 8, N_W2 = 64 * 32, N_EVIN = 16 * 48, N_GLU = 8 * 16, N_ODIN = 16 * 113;
    constexpr int C0 = N_MKV, C1 = C0 + 4 * N_SQ, C2 = C1 + 4 * N_SQ, C3 = C2 + 64 * N_EXP, C4 = C3 + 64 * N_EXP, C5 = C4 + 4 * N_W2,
                  C6 = C5 + 2 * N_EVIN, C7 = C6 + 2 * N_SQ, C8 = C7 + 2 * N_GLU, C9 = C8 + 2 * N_ODIN;
        if (it < C0) { const int r = it; return XI{inp(a, I_WMKV), (bf16_t*)(ws + WS_WMKV), nullptr, 2048, 1024, 64 * (r / 64), 32 * (r % 64), 32 * (r % 64)}; }
        else if (it < C1) { const int r = it - C0, L = r / N_SQ, q = r % N_SQ; return XI{inp(a, I_XWQ) + (size_t)L * 1024 * 1024, (bf16_t*)(ws + WS_WXQ) + (size_t)L * 1024 * 1024, inp(a, I_NXA) + L * D, 1024, 1024, 64 * (q / 32), 32 * (q % 32), 32 * (q % 32)}; }
        else if (it < C2) { const int r = it - C1, L = r / N_SQ, q = r % N_SQ; return XI{inp(a, I_XWO) + (size_t)L * 1024 * 1024, (bf16_t*)(ws + WS_WXO) + (size_t)L * 1024 * 1024, nullptr, 1024, 1024, 64 * (q / 32), 32 * (q % 32), 32 * (q % 32)}; }
        else if (it < C4) { const bool is3 = it >= C3; const int r = is3 ? it - C3 : it - C2, le = r / N_EXP, q = r % N_EXP, L = le / 16, e = le % 16;
            const int n0 = 32 * (q % 8), hh0 = (e % 8) * 256 + n0, rho0 = 256 * (hh0 / 128) + (hh0 % 128) + (is3 ? 128 : 0);
            return XI{inp(a, is3 ? I_W3 : I_W1) + (size_t)le * 1024 * 256, (bf16_t*)(ws + WS_WUP) + (size_t)(L * 2 + e / 8) * 4096 * 1024, inp(a, I_NFFN) + L * D, 256, 1024, 64 * (q / 8), n0, rho0}; }
        else if (it < C5) { const int r = it - C4, L = r / N_W2, q = r % N_W2; const int kg = 64 * (q / 32);
            return XI{inp(a, I_W2) + (size_t)L * 4096 * 1024 + (size_t)(kg & ~1023) * 1024, (bf16_t*)(ws + WS_WDN) + (size_t)L * 1024 * 4096 + (size_t)(kg >> 10) * 1024 * 1024, nullptr, 1024, 1024, kg & 1023, 32 * (q % 32), 32 * (q % 32)}; }
        else if (it < C6) { const int r = it - C5, j = r / N_EVIN, q = r % N_EVIN; return XI{inp(a, I_EVIN) + (size_t)j * 1024 * 1536, (bf16_t*)(ws + WS_WEVIN) + (size_t)j * 1536 * 1024, inp(a, I_NMIX) + (2 * j) * D, 1536, 1024, 64 * (q / 48), 32 * (q % 48), 32 * (q % 48)}; }
        else if (it < C7) { const int r = it - C6, j = r / N_SQ, q = r % N_SQ; return XI{inp(a, I_EVOUT) + (size_t)j * 1024 * 1024, (bf16_t*)(ws + WS_WEVOUT) + (size_t)j * 1024 * 1024, nullptr, 1024, 1024, 64 * (q / 32), 32 * (q % 32), 32 * (q % 32)}; }
        else if (it < C8) { const int r = it - C7, j = r / N_GLU, q = r % N_GLU; return XI{inp(a, I_WGLU) + (size_t)j * 512 * 512, (bf16_t*)(ws + WS_WGLU) + (size_t)j * 512 * 512, nullptr, 512, 512, 64 * (q / 16), 32 * (q % 16), 32 * (q % 16)}; }
        else if (it < C9) { const int r = it - C8, j = r / N_ODIN, q = r % N_ODIN; const int nb = q % 113, d0 = (nb < 112) ? 32 * nb : 3584, s0 = (nb < 112) ? (d0 < 2048 ? d0 : d0 + 8) : 2048;
            return XI{inp(a, I_ODIN) + (size_t)j * 1024 * ODD_IN, (bf16_t*)(ws + WS_WODIN) + (size_t)j * ODD_NP * 1024, inp(a, I_NMIX) + (2 * j + 1) * D, ODD_IN, 1024, 64 * (q / 113), s0, d0}; }
        else { const int r = it - C9, j = r / N_SQ, q = r % N_SQ; return XI{inp(a, I_ODOUT) + (size_t)j * 1024 * 1024, (bf16_t*)(ws + WS_WODOUT) + (size_t)j * 1024 * 1024, nullptr, 1024, 1024, 64 * (q / 32), 32 * (q % 32), 32 * (q % 32)}; }
}
namespace wc {
constexpr int N_MKV = 16 * 64, N_SQ = 16 * 32, N_EXP = 16 * 8, N_W2 = 64 * 32, N_EVIN = 16 * 48, N_GLU = 8 * 16, N_ODIN = 16 * 113;
constexpr int C0 = N_MKV, C1 = C0 + 4 * N_SQ, C2 = C1 + 4 * N_SQ, C3 = C2 + 64 * N_EXP, C4 = C3 + 64 * N_EXP, C5 = C4 + 4 * N_W2,
              C6 = C5 + 2 * N_EVIN, C7 = C6 + 2 * N_SQ, C8 = C7 + 2 * N_GLU, C9 = C8 + 2 * N_ODIN;
constexpr int NL_COMMON = 2 * N_SQ + 32 * N_EXP + N_W2;
__device__ __forceinline__ int layer_items(int L) { return NL_COMMON + ((L & 1) ? (N_ODIN + N_SQ) : (N_EVIN + N_SQ + N_GLU)); }
__device__ __forceinline__ int layer_item(int L, int k) {
    if (k < 0) return k + N_MKV;
    const int j = L >> 1;
    if (k < N_SQ) return C0 + L * N_SQ + k; k -= N_SQ;
    if (k < N_SQ) return C1 + L * N_SQ + k; k -= N_SQ;
    if (k < 16 * N_EXP) return C2 + L * 16 * N_EXP + k; k -= 16 * N_EXP;
    if (k < 16 * N_EXP) return C3 + L * 16 * N_EXP + k; k -= 16 * N_EXP;
    if (k < N_W2) return C4 + L * N_W2 + k; k -= N_W2;
    if (L & 1) { if (k < N_ODIN) return C8 + j * N_ODIN + k; k -= N_ODIN; return C9 + j * N_SQ + k; }
    if (k < N_EVIN) return C5 + j * N_EVIN + k; k -= N_EVIN;
    if (k < N_SQ) return C6 + j * N_SQ + k; k -= N_SQ;
    return C7 + j * N_GLU + k;
}
}
__device__ __forceinline__ void convert_layer(const Args& a, unsigned char* ws, float* scr, int lane, int L, int klo, int w, int nw, int khi = 1 << 30) {
    const int nl = wc::layer_items(L), n = khi < nl ? khi : nl;
    if (klo + w >= n) return;
    XI cur = xi_decode(a, ws, wc::layer_item(L, klo + w)); float va[32], vb[32]; xi_load(cur, lane, va);
    for (int k = klo + w; k < n; k += 2 * nw) {
        const bool h1 = k + nw < n; XI nx = cur; if (h1) { nx = xi_decode(a, ws, wc::layer_item(L, k + nw)); xi_load(nx, lane, vb); }
        xi_finish(cur, va, scr, lane);
        if (!h1) break;
        const bool h2 = k + 2 * nw < n; if (h2) { cur = xi_decode(a, ws, wc::layer_item(L, k + 2 * nw)); xi_load(cur, lane, va); }
        xi_finish(nx, vb, scr, lane);
        if (!h2) break;
    }
}
__device__ __forceinline__ int conv_share0(int L, int G) { if (G != 256 || L + 1 >= DEPTH) return 0; const int pct = (L == 0) ? 25 : (L == 1) ? 12 : 35; return wc::layer_items(L + 1) * pct / 100; }
constexpr int XI_TOTAL = 16 * 64 + 8 * 16 * 32 + 128 * 16 * 8 + 4 * 64 * 32 + 2 * 16 * 48 + 2 * 16 * 32 + 2 * 8 * 16 + 2 * 16 * 113 + 2 * 16 * 32;

__device__ __forceinline__ void ph_prologue(int WV_, const Args& a, unsigned char* lds) {
    const int tid = otid(), lane = tid & 63, wave = __builtin_amdgcn_readfirstlane(tid >> 6);
    const int G = gridDim.x, gw = blockIdx.x * 8 + wave, NGW = G * 8;
    unsigned char* ws = a.ws;
    float* scr = (float*)(lds + wave * 16384);
    convert_layer(a, ws, scr, lane, 0, -wc::N_MKV, gw, NGW);
    const int gt = blockIdx.x * NTHR + tid, NGT = G * NTHR;
    { bf16_t* gm = (bf16_t*)(ws + WS_GMW);
      for (int i = gt; i < 2 * 4 * 128 * 128; i += NGT) { const int s = i & 127, t = (i >> 7) & 127; gm[i] = (s <= t) ? f2bf(inp(a, I_GMWS)[i]) : (bf16_t)0; } }
    { bf16_t* wrb = (bf16_t*)(ws + WS_WRB);
      for (int i = gt; i < 4 * 32 * 1024; i += NGT) { const int k = i & 1023, o = (i >> 10) & 31, L = i >> 15; float w = 0.f;
          if (o < 20) w = inp(a, I_NFFN)[L * D + k] * ((o < 4) ? inp(a, I_WGRP)[((size_t)L * 1024 + k) * 4 + o] : inp(a, I_WEXP)[((size_t)L * 1024 + k) * 16 + (o - 4)]);
          const bf16_t hi = f2bf(w); wrb[((size_t)(L * 2) * 32 + o) * 1024 + k] = hi; wrb[((size_t)(L * 2 + 1) * 32 + o) * 1024 + k] = f2bf(w - bf2f(hi)); }
      for (int i = gt; i < 2 * 224 * 1024 / 8; i += NGT) { const int j = i / (224 * 128), r = i % (224 * 128);
          *(u32x4*)((bf16_t*)(ws + WS_WODIN) + ((size_t)j * ODD_NP + 3616) * 1024 + (size_t)r * 8) = zero4(); }
    }
    { float* lamb = (float*)(ws + WS_LAMB); float* bbar = (float*)(ws + WS_BBAR);
      for (int i = gt; i < 2 * 32 * 64; i += NGT) { const int jg = i >> 6;
          const float lr = inp(a, I_LAMRE)[i], li = inp(a, I_LAMIM)[i], step = expf(inp(a, I_LOGSTEP)[jg]);
          const float mag = expf(lr * step), ang = li * step; float sn, cs; sn = sinf(ang); cs = cosf(ang);
          const float br = mag * cs, bi = mag * sn;
          lamb[2 * i] = br; lamb[2 * i + 1] = bi;
          const float nr = br - 1.f, ni = bi, den = lr * lr + li * li;
          const float cr = (nr * lr + ni * li) / den, ci = (ni * lr - nr * li) / den;
          for (int k = 0; k < 16; ++k) { const float xr = inp(a, I_BRE)[(size_t)i * 16 + k], xi = inp(a, I_BIM)[(size_t)i * 16 + k];
              bbar[((size_t)i * 16 + k) * 2] = cr * xr - ci * xi; bbar[((size_t)i * 16 + k) * 2 + 1] = cr * xi + ci * xr; } } }
    if (blockIdx.x == 0 && tid < 256) ((int*)(ws + WS_MCNT))[tid] = 0;
    { bf16_t* hb = (bf16_t*)(ws + WS_XN); float* ss0 = (float*)(ws + WS_SS);
      for (int m = gw; m < T; m += NGW) {
          const f32x4* xr = (const f32x4*)(inp(a, I_X) + (size_t)m * D) + lane; u32x2* o8 = (u32x2*)(hb + (size_t)m * D) + lane; float sq = 0.f;
#pragma unroll
          for (int j = 0; j < 4; ++j) { const f32x4 v = xr[64 * j]; sq += (v.x * v.x + v.y * v.y) + (v.z * v.z + v.w * v.w);
              u32x2 o; o.x = pk2(v.x, v.y); o.y = pk2(v.z, v.w); o8[64 * j] = o; }
          sq = wave_sum(sq); if (lane < 16) ss0[(size_t)m * 16 + lane] = (lane == 0) ? sq : 0.f; } }
    { const float* gp = inp(a, I_MEMG); bf16_t* mn = (bf16_t*)(ws + WS_MEMN);
      for (int m = gw; m < BATCH * NMEM; m += NGW) {
          const f32x4* xr = (const f32x4*)(inp(a, I_MEM) + (size_t)m * D) + lane; f32x4 v[4]; float s = 0.f;
#pragma unroll
          for (int j = 0; j < 4; ++j) { v[j] = xr[64 * j]; s += (v[j].x * v[j].x + v[j].y * v[j].y) + (v[j].z * v[j].z + v[j].w * v[j].w); }
          const float rstd = 1.f / sqrtf(wave_sum(s) * (1.f / D) + EPS);
          u32x2* o8 = (u32x2*)(mn + (size_t)m * D) + lane;
#pragma unroll
          for (int j = 0; j < 4; ++j) { const f32x4 gg = ((const f32x4*)gp)[lane + 64 * j];
              u32x2 o; o.x = pk2(v[j].x * rstd * gg.x, v[j].y * rstd * gg.y); o.y = pk2(v[j].z * rstd * gg.z, v[j].w * rstd * gg.w); o8[64 * j] = o; } } }
}

template <int NOUT>
__device__ __forceinline__ void ph_norm(int WV_, const float* h, const float* g, bf16_t* xn, const float* wt, const float* bias_grp, const float* bias_exp, float* outv) {
    const int tid = otid(), lane = tid & 63, wave = __builtin_amdgcn_readfirstlane(tid >> 6);
    const int gw = blockIdx.x * 8 + wave, NGW = gridDim.x * 8;
    f32x4 gg[4];
#pragma unroll
    for (int j = 0; j < 4; ++j) gg[j] = ((const f32x4*)g)[lane + 64 * j];
    for (int m = gw; m < T; m += NGW) {
        const f32x4* xr = (const f32x4*)(h + (size_t)m * D) + lane; f32x4 v[4]; float s = 0.f;
#pragma unroll
        for (int j = 0; j < 4; ++j) { v[j] = xr[64 * j]; s += (v[j].x * v[j].x + v[j].y * v[j].y) + (v[j].z * v[j].z + v[j].w * v[j].w); }
        const float rstd = 1.f / sqrtf(wave_sum(s) * (1.f / D) + EPS);
        u32x2* o8 = (u32x2*)(xn + (size_t)m * D) + lane;
#pragma unroll
        for (int j = 0; j < 4; ++j) { v[j].x *= rstd * gg[j].x; v[j].y *= rstd * gg[j].y; v[j].z *= rstd * gg[j].z; v[j].w *= rstd * gg[j].w;
            u32x2 o; o.x = pk2(v[j].x, v[j].y); o.y = pk2(v[j].z, v[j].w); o8[64 * j] = o; }
        if constexpr (NOUT > 0) {
            float mine = 0.f;
#pragma unroll 1
            for (int o = 0; o < NOUT; ++o) { float p = 0.f;
#pragma unroll
                for (int j = 0; j < 4; ++j) { const f32x4 w = ((const f32x4*)(wt + (size_t)o * D))[lane + 64 * j]; p += (v[j].x * w.x + v[j].y * w.y) + (v[j].z * w.z + v[j].w * w.w); }
                p = wave_sum(p); mine = (lane == o) ? p : mine; }
            if constexpr (NOUT == 8) { if (lane < 8) outv[(size_t)m * 8 + lane] = mine; }
            if constexpr (NOUT == 20) {
                float dots[20];
#pragma unroll
                for (int o = 0; o < 20; ++o) dots[o] = __builtin_bit_cast(float, __builtin_amdgcn_readlane(__builtin_bit_cast(int, mine), o));
                float gl[4];
#pragma unroll
                for (int o = 0; o < 4; ++o) gl[o] = dots[o] + bias_grp[o];
                int grp = 0; float gmax = gl[0];
#pragma unroll
                for (int o = 1; o < 4; ++o) if (gl[o] > gmax) { gmax = gl[o]; grp = o; }
                float gs = 0.f;
#pragma unroll
                for (int o = 0; o < 4; ++o) gs += __expf(gl[o] - gmax);
                const float gp = 1.f / gs;
                float sl[4];
#pragma unroll
                for (int o = 0; o < 4; ++o) { float x = dots[4 + o] + bias_exp[o];
#pragma unroll
                    for (int q = 1; q < 4; ++q) x = (grp == q) ? dots[4 + 4 * q + o] + bias_exp[4 * q + o] : x;
                    sl[o] = x; }
                int i0 = 0; float v0 = sl[0];
#pragma unroll
                for (int o = 1; o < 4; ++o) if (sl[o] > v0) { v0 = sl[o]; i0 = o; }
                int i1 = -1; float v1 = -3.0e38f;
#pragma unroll
                for (int o = 0; o < 4; ++o) if (o != i0 && sl[o] > v1) { v1 = sl[o]; i1 = o; }
                const float e1 = __expf(v1 - v0), w0 = gp / (1.f + e1), w1 = gp * e1 / (1.f + e1);
                if (lane < 16) { const int ge = lane >> 2, le = lane & 3; float w = 0.f; if (ge == grp) w = (le == i0) ? w0 : ((le == i1) ? w1 : 0.f); outv[(size_t)m * 16 + lane] = w; }
            }
        }
    }
}


__device__ __forceinline__ void ph_router(int WV_, unsigned char* lds, const bf16_t* hb, const bf16_t* wrb  , const float* bias_grp, const float* bias_exp, int* cnt, int* idx, float* gs, float* rstd_slot, int chunk0, int cstride) {
    const int tid = otid(), lane = tid & 63, wave = __builtin_amdgcn_readfirstlane(tid >> 6), mt = wave & 3, kh = wave >> 2;
    constexpr int LDW = 2048 + 16;
    unsigned char* wl = lds;
    float* lg = (float*)(lds + 48 * LDW);
    float* sqp = lg + 2 * 64 * 33;
    float* rs_l = sqp + 128;
    for (int chunk = chunk0; chunk < T / 64; chunk += cstride) {
        __syncthreads();
        const bf16_t* arow = hb + (size_t)(chunk * 64 + 16 * mt + (lane & 15)) * D + kh * 512 + 8 * (lane >> 4);
        u32x4 av[16], wv[12];
#pragma unroll
        for (int ks = 0; ks < 16; ++ks) av[ks] = *(const u32x4*)(arow + 32 * ks);
#pragma unroll
        for (int i = 0; i < 12; ++i) { const int p = tid + NTHR * i, r48 = p >> 7; wv[i] = *(const u32x4*)(wrb + (size_t)(r48 + ((r48 >= 24) ? 8 : 0)) * 1024 + (p & 127) * 8); }
#pragma unroll
        for (int i = 0; i < 12; ++i) { const int p = tid + NTHR * i; *(u32x4*)(wl + (p >> 7) * LDW + (p & 127) * 16) = wv[i]; }
        __syncthreads();
        f32x4 acc[2] = {(f32x4){0.f, 0.f, 0.f, 0.f}, (f32x4){0.f, 0.f, 0.f, 0.f}}; float sq = 0.f;
#pragma unroll
        for (int ks = 0; ks < 16; ++ks) { float f[8]; unpack8(av[ks], f);
#pragma unroll
            for (int j = 0; j < 8; ++j) sq += f[j] * f[j];
            const bf16x8 a8 = __builtin_bit_cast(bf16x8, av[ks]);
#pragma unroll
            for (int nt = 0; nt < 2; ++nt) { const int wr_ = (16 * nt + (lane & 15)) < 23 ? (16 * nt + (lane & 15)) : 23; const unsigned char* wp = wl + wr_ * LDW + (kh * 512 + 32 * ks + 8 * (lane >> 4)) * 2;
                acc[nt] = MFMA16(a8, *(const bf16x8*)wp, acc[nt]); acc[nt] = MFMA16(a8, *(const bf16x8*)(wp + 24 * LDW), acc[nt]); } }
        sq = sum_rows(sq);
        if (lane < 16) sqp[kh * 64 + 16 * mt + lane] = sq;
#pragma unroll
        for (int nt = 0; nt < 2; ++nt)
#pragma unroll
            for (int r = 0; r < 4; ++r) lg[(kh * 64 + 16 * mt + 4 * (lane >> 4) + r) * 33 + 16 * nt + (lane & 15)] = acc[nt][r];
        __syncthreads();
        if (wave == 0) { rs_l[lane] = 1.f / sqrtf((sqp[lane] + sqp[64 + lane]) * (1.f / D) + EPS);
#pragma unroll
            for (int o = 0; o < 20; ++o) lg[lane * 33 + o] += lg[(64 + lane) * 33 + o]; }
        if (wave == 0) {
            const float rstd = rs_l[lane]; float dots[20];
#pragma unroll
            for (int o = 0; o < 20; ++o) dots[o] = lg[lane * 33 + o] * rstd;
            float gl[4];
#pragma unroll
            for (int o = 0; o < 4; ++o) gl[o] = dots[o] + bias_grp[o];
            int grp = 0; float gmax = gl[0];
#pragma unroll
            for (int o = 1; o < 4; ++o) if (gl[o] > gmax) { gmax = gl[o]; grp = o; }
            float gsum = 0.f;
#pragma unroll
            for (int o = 0; o < 4; ++o) gsum += __expf(gl[o] - gmax);
            const float gp = 1.f / gsum;
            float sl[4];
#pragma unroll
            for (int o = 0; o < 4; ++o) { float x = dots[4 + o] + bias_exp[o];
#pragma unroll
                for (int q = 1; q < 4; ++q) x = (grp == q) ? dots[4 + 4 * q + o] + bias_exp[4 * q + o] : x;
                sl[o] = x; }
            int i0 = 0; float v0 = sl[0];
#pragma unroll
            for (int o = 1; o < 4; ++o) if (sl[o] > v0) { v0 = sl[o]; i0 = o; }
            int i1 = -1; float v1 = -3.0e38f;
#pragma unroll
            for (int o = 0; o < 4; ++o) if (o != i0 && sl[o] > v1) { v1 = sl[o]; i1 = o; }
            const float e1 = __expf(v1 - v0), w0 = gp / (1.f + e1), w1 = gp * e1 / (1.f + e1);
            const int ilo = (i0 < i1) ? i0 : i1, ihi = (i0 < i1) ? i1 : i0; const float wlo = (i0 < i1) ? w0 : w1, whi = (i0 < i1) ? w1 : w0;
            const int gq = grp * 6 + ((ilo * (7 - ilo)) >> 1) + (ihi - ilo - 1);
            int mycnt = 0, rank = 0;
#pragma unroll 4
            for (int bq = 0; bq < 24; ++bq) { const unsigned long long mb = __ballot(gq == bq); if (lane == bq) mycnt = (int)__popcll(mb); if (gq == bq) rank = (int)__popcll(mb & ((1ull << lane) - 1ull)); }
            int basev = 0;
            if (lane < 24 && mycnt > 0) basev = atomicAdd(&cnt[lane], mycnt);
            const int mybase = __builtin_bit_cast(int, __builtin_amdgcn_ds_bpermute(gq << 2, basev));
            const size_t pos = (size_t)gq * T + mybase + rank; idx[pos] = chunk * 64 + lane; *(f32x2*)(gs + pos * 2) = (f32x2){wlo, whi}; rstd_slot[pos] = rstd; }
    }
}
struct BselUp { const bf16_t* base; __device__ __forceinline__ const char* operator()(const pg8::GUnit& u) const { return (const char*)(base + (size_t)((u.g >> 1) * 4096 + (u.g & 1) * 2048 + u.pn * 256) * 1024); } };
struct BselMoe { const bf16_t* up; const bf16_t* dn; __device__ __forceinline__ const char* operator()(const pg8::MUnit& u) const {
    return u.kind ? (const char*)(dn + ((size_t)u.g * 1024 + u.pn * 256) * 1024) : (const char*)(up + (size_t)((u.g >> 1) * 4096 + (u.g & 1) * 2048 + u.pn * 256) * 1024); } };
struct BselMoe2 { const bf16_t* up; const bf16_t* dn; __device__ __forceinline__ const char* operator()(const pg8::MUnit2& u) const {
    const int e = u.elo() + (u.pn >> 1) * (u.ehi() - u.elo());
    return u.kind ? (const char*)(dn + ((size_t)u.g() * 1024 + u.pn * 256) * 1024 + u.elo() * 256) : (const char*)(up + (size_t)(((u.g() * 4 + e) * 2 + (u.pn & 1)) * 256) * 1024); } };

__device__ __forceinline__ void ph_s5(int WV_, unsigned char* lds, const bf16_t* zs, bf16_t* ys, const float* lamb, const float* bbar, const float* cre, const float* cim, const float* dskip, const Items it) {
    const int tid = otid(), lane = tid & 63, wave = WV_;
    constexpr int LDU = 80, LDX = 272;
    unsigned char* BtB = lds;
    unsigned char* CtB = BtB + 128 * LDU;
    unsigned char* Ub = CtB + 16 * LDX;
    float* BUf = (float*)(Ub + 3 * 64 * LDU);
    unsigned char* Xb = (unsigned char*)(BUf + 2 * 64 * 128);
    float* XE = (float*)(Xb + 2 * 64 * LDX);
    for (int k_ = 0, item = it.first; k_ < it.count; ++k_, item += it.stride) {
        const int b = item >> 5, g = item & 31;
        __syncthreads();
        for (int i = tid; i < 128 * 32; i += NTHR) { const int n = i >> 5, k = i & 31; float v = 0.f;
            if (k < 16) v = bbar[((size_t)(g * 64 + (n >> 1)) * 16 + k) * 2 + (n & 1)];
            *(bf16_t*)(BtB + n * LDU + k * 2) = f2bf(v); }
        for (int i = tid; i < 16 * 128; i += NTHR) { const int n = i >> 7, k = i & 127;
            const float v = (k & 1) ? -cim[(size_t)(g * 16 + n) * 64 + (k >> 1)] : cre[(size_t)(g * 16 + n) * 64 + (k >> 1)];
            *(bf16_t*)(CtB + n * LDX + k * 2) = f2bf(v); }
        for (int i = tid; i < 3 * 64; i += NTHR) { const u32x4 z4 = zero4(); *(u32x4*)(Ub + i * LDU + 32) = z4; *(u32x4*)(Ub + i * LDU + 48) = z4; }
        float lr = 0.f, li = 0.f; f32x2 pw[16]; f32x2 l32 = {0.f, 0.f}, l48 = {0.f, 0.f}, l64 = {0.f, 0.f}; f32x2 xin = {0.f, 0.f};
#pragma unroll
        for (int j = 0; j < 16; ++j) pw[j] = (f32x2){0.f, 0.f};
        if (wave < 4) { lr = lamb[(g * 64 + lane) * 2]; li = lamb[(g * 64 + lane) * 2 + 1]; pw[0] = (f32x2){lr, li};
#pragma unroll
            for (int j = 1; j < 16; ++j) pw[j] = (f32x2){pw[j - 1].x * lr - pw[j - 1].y * li, pw[j - 1].x * li + pw[j - 1].y * lr};
            l32 = (f32x2){pw[15].x * pw[15].x - pw[15].y * pw[15].y, 2.f * pw[15].x * pw[15].y};
            l48 = (f32x2){l32.x * pw[15].x - l32.y * pw[15].y, l32.x * pw[15].y + l32.y * pw[15].x};
            l64 = (f32x2){l32.x * l32.x - l32.y * l32.y, 2.f * l32.x * l32.y}; }
        const float dsk = dskip[g * 16 + (lane & 15)];
        const int ul = tid - 256, ut = (ul >> 2) & 63, uq = ul & 3;
        const bf16_t* usrc = zs + ((size_t)b * SEQ + ut) * MIX + g * 16 + 4 * uq;
        u32x2 ureg = (u32x2){0u, 0u};
        if (wave >= 4) ureg = *(const u32x2*)usrc;
        f32x2 xl[16];
#pragma unroll
        for (int j = 0; j < 16; ++j) xl[j] = (f32x2){0.f, 0.f};
        for (int c = -1; c <= SEQ / 64; ++c) {
            if (wave >= 4) {
                if (c + 1 < SEQ / 64) *(u32x2*)(Ub + ((c + 1) % 3) * 64 * LDU + ut * LDU + uq * 8) = ureg;
                if (wave <= 5 && c >= 1) { const int cc = c - 1; const unsigned char* xa = Xb + (cc & 1) * 64 * LDX; const unsigned char* ub = Ub + (cc % 3) * 64 * LDU;
                    f32x4 acc[2] = {(f32x4){0.f, 0.f, 0.f, 0.f}, (f32x4){0.f, 0.f, 0.f, 0.f}};
#pragma unroll
                    for (int ks = 0; ks < 4; ++ks) { const bf16x8 bf = frag_row((const LAS unsigned char*)CtB, LDX, 0, 32 * ks, lane);
#pragma unroll
                        for (int mi = 0; mi < 2; ++mi) acc[mi] = MFMA16(frag_row((const LAS unsigned char*)xa, LDX, 16 * (2 * (wave - 4) + mi), 32 * ks, lane), bf, acc[mi]); }
#pragma unroll
                    for (int mi = 0; mi < 2; ++mi)
#pragma unroll
                        for (int r = 0; r < 4; ++r) { const int t = 16 * (2 * (wave - 4) + mi) + 4 * (lane >> 4) + r;
                            const float u = bf2f(*(const bf16_t*)(ub + t * LDU + (lane & 15) * 2));
                            ys[((size_t)b * SEQ + cc * 64 + t) * MIX + g * 16 + (lane & 15)] = f2bf(gelu_tanh(acc[mi][r] + dsk * u)); } }
            } else if (c >= 0 && c < SEQ / 64) {
                const float* bu = BUf + (c & 1) * 64 * 128 + (16 * wave) * 128 + 2 * lane; f32x2 bb[16];
#pragma unroll
                for (int j = 0; j < 16; ++j) bb[j] = *(const f32x2*)(bu + j * 128);
                float xr = 0.f, xi = 0.f;
#pragma unroll
                for (int j = 0; j < 16; ++j) { const float nr = lr * xr - li * xi + bb[j].x, ni = lr * xi + li * xr + bb[j].y; xr = nr; xi = ni; xl[j] = (f32x2){xr, xi}; }
                *(f32x2*)(XE + (wave * 64 + lane) * 2) = (f32x2){xr, xi};
            }
            __syncthreads();
            if (wave >= 4) { if (c + 1 < SEQ / 64) { const int cc = c + 1; const unsigned char* ua = Ub + (cc % 3) * 64 * LDU; float* bo = BUf + (cc & 1) * 64 * 128;
                bf16x8 af[4];
#pragma unroll
                for (int mt = 0; mt < 4; ++mt) af[mt] = frag_row((const LAS unsigned char*)ua, LDU, 16 * mt, 0, lane);
#pragma unroll
                for (int nn = 0; nn < 2; ++nn) { const int nt = 2 * (wave - 4) + nn; const bf16x8 bf = frag_row((const LAS unsigned char*)BtB, LDU, 16 * nt, 0, lane);
#pragma unroll
                    for (int mt = 0; mt < 4; ++mt) { f32x4 a4 = MFMA16(af[mt], bf, ((f32x4){0.f, 0.f, 0.f, 0.f}));
#pragma unroll
                        for (int r = 0; r < 4; ++r) bo[(16 * mt + 4 * (lane >> 4) + r) * 128 + 16 * nt + (lane & 15)] = a4[r]; } }
                if (c + 2 < SEQ / 64) ureg = *(const u32x2*)(usrc + (size_t)(c + 2) * 64 * MIX); } }
            else if (c >= 0 && c < SEQ / 64) {
                const f32x2 e0 = *(const f32x2*)(XE + (0 * 64 + lane) * 2), e1 = *(const f32x2*)(XE + (1 * 64 + lane) * 2), e2 = *(const f32x2*)(XE + (2 * 64 + lane) * 2), e3 = *(const f32x2*)(XE + (3 * 64 + lane) * 2);
#define CMUL(a_, b_) ((f32x2){(a_).x * (b_).x - (a_).y * (b_).y, (a_).x * (b_).y + (a_).y * (b_).x})
                const f32x2 l16 = pw[15];
                const f32x2 b0 = xin; f32x2 t1 = CMUL(l16, b0); const f32x2 b1 = (f32x2){t1.x + e0.x, t1.y + e0.y};
                f32x2 t2 = CMUL(l16, b1); const f32x2 b2 = (f32x2){t2.x + e1.x, t2.y + e1.y};
                f32x2 t3 = CMUL(l16, b2); const f32x2 b3 = (f32x2){t3.x + e2.x, t3.y + e2.y};
                f32x2 t4 = CMUL(l16, b3); xin = (f32x2){t4.x + e3.x, t4.y + e3.y};
                const f32x2 xb = (wave == 0) ? b0 : (wave == 1) ? b1 : (wave == 2) ? b2 : b3;
                unsigned char* xo = Xb + (c & 1) * 64 * LDX + (16 * wave) * LDX + lane * 4;
#pragma unroll
                for (int j = 0; j < 16; ++j) { const f32x2 fx = CMUL(pw[j], xb); *(unsigned*)(xo + j * LDX) = pk2(xl[j].x + fx.x, xl[j].y + fx.y); }
#undef CMUL
                (void)l32; (void)l48; (void)l64;
            }
            __syncthreads();
        }
    }
}

constexpr int LD128 = 272;
constexpr int TILE128 = 128 * LD128;
__device__ __forceinline__ void ph_gmlp(int WV_, unsigned char* lds, const bf16_t* zuv, bf16_t* cat, const bf16_t* gmw, const float* gbs, const float* lng, int wg, int nwg, int ilim) {
    const int tid = otid(), lane = tid & 63, wave = __builtin_amdgcn_readfirstlane(tid >> 6), wm = wave >> 1, wn = wave & 1;
    unsigned char* Wl = lds; unsigned char* Vl = lds + TILE128;
    int hst = -1;
    for (int item = wg; item < BATCH * 16 * 4 && item < ilim; item += nwg) {
        const int h = item & 3, bc = item >> 2; const size_t tok0 = (size_t)bc * 128;
        __syncthreads();
        if (h != hst) { stage_tile(Wl, LD128, gmw + (size_t)h * 128 * 128, 128, 128, 128, tid); hst = h; }
        { const int s = tid >> 2, q = tid & 3; const bf16_t* src = zuv + (tok0 + s) * 1024 + 512 + h * 128 + q * 32;
          float v[32];
#pragma unroll
          for (int c = 0; c < 4; ++c) { float f[8]; unpack8(*(const u32x4*)(src + 8 * c), f);
#pragma unroll
              for (int j = 0; j < 8; ++j) v[8 * c + j] = f[j]; }
          float sm = 0.f;
#pragma unroll
          for (int j = 0; j < 32; ++j) sm += v[j];
          sm = sum4(sm);
          const float mean = sm * (1.f / 128.f); float sq = 0.f;
#pragma unroll
          for (int j = 0; j < 32; ++j) { v[j] -= mean; sq += v[j] * v[j]; }
          sq = sum4(sq);
          const float rstd = 1.f / sqrtf(sq * (1.f / 128.f) + EPS);
#pragma unroll
          for (int c = 0; c < 4; ++c) { float f[8];
#pragma unroll
              for (int j = 0; j < 8; ++j) f[j] = v[8 * c + j] * rstd * lng[h * 128 + q * 32 + 8 * c + j];
              *(u32x4*)(Vl + s * LD128 + (q * 32 + 8 * c) * 2) = pack8(f); } }
        __syncthreads();
        f32x4 acc[2][4];
#pragma unroll
        for (int mi = 0; mi < 2; ++mi)
#pragma unroll
            for (int ni = 0; ni < 4; ++ni) acc[mi][ni] = (f32x4){0.f, 0.f, 0.f, 0.f};
        for (int ks = 0; ks <= wm; ++ks) {
            bf16x8 af[2], bfr[4];
#pragma unroll
            for (int mi = 0; mi < 2; ++mi) af[mi] = frag_row((const LAS unsigned char*)Wl, LD128, 32 * wm + 16 * mi, 32 * ks, lane);
#pragma unroll
            for (int ni = 0; ni < 4; ++ni) bfr[ni] = frag_tr((const LAS unsigned char*)Vl, LD128, 32 * ks, 64 * wn + 16 * ni, lane);
#pragma unroll
            for (int mi = 0; mi < 2; ++mi)
#pragma unroll
                for (int ni = 0; ni < 4; ++ni) acc[mi][ni] = MFMA16(af[mi], bfr[ni], acc[mi][ni]);
        }
        float uv[2][4][4], bsv[2][4];
#pragma unroll
        for (int mi = 0; mi < 2; ++mi)
#pragma unroll
            for (int r = 0; r < 4; ++r) { const int t = 32 * wm + 16 * mi + 4 * (lane >> 4) + r; bsv[mi][r] = gbs[h * 128 + t];
#pragma unroll
                for (int ni = 0; ni < 4; ++ni) uv[mi][r][ni] = bf2f(zuv[(tok0 + t) * 1024 + h * 128 + 64 * wn + 16 * ni + (lane & 15)]); }
        __builtin_amdgcn_sched_barrier(0);
#pragma unroll
        for (int mi = 0; mi < 2; ++mi)
#pragma unroll
            for (int r = 0; r < 4; ++r) { const int t = 32 * wm + 16 * mi + 4 * (lane >> 4) + r;
#pragma unroll
                for (int ni = 0; ni < 4; ++ni) { const int d = 64 * wn + 16 * ni + (lane & 15);
                    cat[(tok0 + t) * 1024 + h * 128 + d] = f2bf(uv[mi][r][ni] * (acc[mi][ni][r] + bsv[mi][r])); } }
    }
}

__device__ __forceinline__ float lds_sum128_le(const float* a, int t) {
    float s = 0.f;
#pragma unroll 8
    for (int j4 = 0; j4 < 32; ++j4) { const f32x4 v = ((const f32x4*)a)[j4]; const int j = 4 * j4;
        s += ((j <= t) ? v[0] : 0.f) + ((j + 1 <= t) ? v[1] : 0.f) + ((j + 2 <= t) ? v[2] : 0.f) + ((j + 3 <= t) ? v[3] : 0.f); }
    return s;
}
__device__ __forceinline__ float lds_max128_le(const float* a, int t) {
    float m = -3.0e38f;
#pragma unroll 8
    for (int j4 = 0; j4 < 32; ++j4) { const f32x4 v = ((const f32x4*)a)[j4]; const int j = 4 * j4;
        m = fmaxf(m, fmaxf(fmaxf((j <= t) ? v[0] : -3.0e38f, (j + 1 <= t) ? v[1] : -3.0e38f), fmaxf((j + 2 <= t) ? v[2] : -3.0e38f, (j + 3 <= t) ? v[3] : -3.0e38f))); }
    return m;
}
__device__ __forceinline__ float lds_sum128(const float* a) {
    float s = 0.f;
#pragma unroll 8
    for (int j4 = 0; j4 < 32; ++j4) { const f32x4 v = ((const f32x4*)a)[j4]; s += (v[0] + v[1]) + (v[2] + v[3]); }
    return s;
}
__device__ __forceinline__ float lds_max128(const float* a) {
    float m = -3.0e38f;
#pragma unroll 8
    for (int j4 = 0; j4 < 32; ++j4) { const f32x4 v = ((const f32x4*)a)[j4]; m = fmaxf(m, fmaxf(fmaxf(v[0], v[1]), fmaxf(v[2], v[3]))); }
    return m;
}
__device__ __forceinline__ float lds_dot128(const unsigned char* row, const float* vec) {
    float s = 0.f;
#pragma unroll 4
    for (int c = 0; c < 16; ++c) { float f[8]; unpack8(*(const u32x4*)(row + 16 * c), f); const f32x4 a = ((const f32x4*)vec)[2 * c], b = ((const f32x4*)vec)[2 * c + 1];
        s += (f[0] * a[0] + f[1] * a[1]) + (f[2] * a[2] + f[3] * a[3]) + (f[4] * b[0] + f[5] * b[1]) + (f[6] * b[2] + f[7] * b[3]); }
    return s;
}
__device__ __forceinline__ void conv_silu32(const bf16_t* zrow  , int pos, const float* cw  , const float* cb, float scale, float (&out)[32]) {
#pragma unroll
    for (int c = 0; c < 4; ++c)
#pragma unroll
        for (int j = 0; j < 8; ++j) out[8 * c + j] = cb[8 * c + j];
#pragma unroll
    for (int tp = 0; tp < 2; ++tp) {
        u32x4 raw[2][4];
#pragma unroll
        for (int t2 = 0; t2 < 2; ++t2) { const int tap = 2 * tp + t2; const bf16_t* src = (pos - 3 + tap >= 0) ? zrow - (size_t)(3 - tap) * ODD_N : zrow;
#pragma unroll
            for (int c = 0; c < 4; ++c) raw[t2][c] = *(const u32x4*)(src + 8 * c); }
#pragma unroll
        for (int t2 = 0; t2 < 2; ++t2) { const int tap = 2 * tp + t2; const float tv = (pos - 3 + tap >= 0) ? 1.f : 0.f;
#pragma unroll
            for (int c = 0; c < 4; ++c) { float f[8]; unpack8(raw[t2][c], f);
#pragma unroll
                for (int j = 0; j < 8; ++j) out[8 * c + j] += (tv * cw[tap * 1024 + 8 * c + j]) * f[j]; } }
        __builtin_amdgcn_sched_barrier(0);
    }
#pragma unroll
    for (int j = 0; j < 32; ++j) out[j] = siluf_(out[j]) * scale;
    __builtin_amdgcn_sched_barrier(0);
}

__device__ __forceinline__ void conv_stage_weights(float* cwl, const float* convw, const float* convb, int h, int p0, int nparts, int tid) {
    for (int i = tid; i < nparts * 640; i += NTHR) { const int isb = i >= nparts * 512; const int r = isb ? i - nparts * 512 : i;
        const int p = isb ? r >> 7 : r >> 9, tap = (r >> 7) & 3, ch = r & 127;
        cwl[i] = isb ? convb[512 * (p0 + p) + h * 128 + ch] : convw[tap * 1024 + 512 * (p0 + p) + h * 128 + ch]; }
}
__device__ __forceinline__ void conv_load(const bf16_t* zrow  , int pos, u32x4 (&raw)[4][4]) {
#pragma unroll
    for (int tap = 0; tap < 4; ++tap) { const bf16_t* src = (pos - 3 + tap >= 0) ? zrow - (size_t)(3 - tap) * ODD_N : zrow;
#pragma unroll
        for (int c = 0; c < 4; ++c) raw[tap][c] = *(const u32x4*)(src + 8 * c); }
}
template <int TS = 1024>
__device__ __forceinline__ void conv_finish(const u32x4 (&raw)[4][4], int pos, const float* cw  , const float* cb, float scale, unsigned char* dst  ) {
#pragma unroll
    for (int c = 0; c < 4; ++c) { float o[8];
#pragma unroll
        for (int j = 0; j < 8; ++j) o[j] = cb[8 * c + j];
#pragma unroll
        for (int tap = 0; tap < 4; ++tap) { const float tv = (pos - 3 + tap >= 0) ? 1.f : 0.f; float f[8]; unpack8(raw[tap][c], f);
#pragma unroll
            for (int j = 0; j < 8; ++j) o[j] += (tv * cw[tap * TS + 8 * c + j]) * f[j]; }
#pragma unroll
        for (int j = 0; j < 8; ++j) o[j] = siluf_(o[j]) * scale;
        *(u32x4*)(dst + 16 * c) = pack8(o);
        __builtin_amdgcn_sched_barrier(0); }
}

__device__ __forceinline__ void ph_mlstm1(int WV_, unsigned char* lds, const bf16_t* z, const float* gates, const float* bif, const float* convw, const float* convb,
                                          bf16_t* kv, float* nloc, float* mloc, float* gsum, const Items it) {
    const int tid = otid(), lane = tid & 63, wave = __builtin_amdgcn_readfirstlane(tid >> 6), wm = wave >> 1, wn = wave & 1;
    unsigned char* Kl = lds; unsigned char* Vl = lds + TILE128; float* fa = (float*)(lds + 2 * TILE128);
    float* cwl = fa + 1024;
    int hst = -1;
    for (int k_ = 0, item = it.first; k_ < it.count; ++k_, item += it.stride) {
        const int c = item & 15, h = (item >> 4) & 3, b = item >> 6; const size_t tok0 = (size_t)b * SEQ + c * 128;
        __syncthreads();
        if (h != hst) { conv_stage_weights(cwl, convw, convb, h, 1, 1, tid); hst = h; }
        const int l = tid >> 2, q = tid & 3;
        u32x4 rk[4][4], rv[4];
        conv_load(z + (tok0 + l) * ODD_N + 512 + h * 128 + q * 32, c * 128 + l, rk);
#pragma unroll
        for (int jj = 0; jj < 4; ++jj) { const int i = tid + NTHR * jj; rv[jj] = *(const u32x4*)(z + (tok0 + (i >> 4)) * ODD_N + 1024 + h * 128 + (i & 15) * 8); }
        float ml = 0.f, gtot = 0.f;
        if (wave == 0) {
            const float* gp = gates + (tok0 + 2 * lane) * 8; const float bf_ = bif[4 + h], bi_ = bif[h];
            const float f0 = gp[4 + h], f1 = gp[12 + h], i0 = gp[h], i1 = gp[8 + h];
            const float lf0 = logsigmoidf_(f0 + bf_), lf1 = logsigmoidf_(f1 + bf_);
            const float S = wave_scan_add(lf0 + lf1);
            gtot = __builtin_bit_cast(float, __builtin_amdgcn_readlane(__builtin_bit_cast(int, S), 63));
            const float a0 = (gtot - (S - lf1)) + i0 + bi_, a1 = (gtot - S) + i1 + bi_;
            float mx = max16(fmaxf(a0, a1)); mx = fmaxf(mx, xor16f(mx)); ml = max_x32(mx);
            *(f32x2*)(fa + 256 + 2 * lane) = (f32x2){fexp(a0 - ml), fexp(a1 - ml)};
        }
        __syncthreads();
        conv_finish<128>(rk, c * 128 + l, cwl + q * 32, cwl + 512 + q * 32, 0.08838834764831845f * fa[256 + l], Kl + l * LD128 + q * 64);
#pragma unroll
        for (int jj = 0; jj < 4; ++jj) { const int i = tid + NTHR * jj; *(u32x4*)(Vl + (i >> 4) * LD128 + (i & 15) * 16) = rv[jj]; }
        __syncthreads();
        f32x4 acc[2][4], nacc[4];
        const bf16x8 ones = __builtin_bit_cast(bf16x8, (u32x4){0x3F803F80u, 0x3F803F80u, 0x3F803F80u, 0x3F803F80u});
#pragma unroll
        for (int mi = 0; mi < 2; ++mi)
#pragma unroll
            for (int ni = 0; ni < 4; ++ni) { acc[mi][ni] = (f32x4){0.f, 0.f, 0.f, 0.f}; nacc[ni] = (f32x4){0.f, 0.f, 0.f, 0.f}; }
#pragma unroll
        for (int ks = 0; ks < 4; ++ks) {
            bf16x8 af[2], bfr[4];
#pragma unroll
            for (int mi = 0; mi < 2; ++mi) af[mi] = frag_tr((const LAS unsigned char*)Vl, LD128, 32 * ks, 32 * wm + 16 * mi, lane);
#pragma unroll
            for (int ni = 0; ni < 4; ++ni) bfr[ni] = frag_tr((const LAS unsigned char*)Kl, LD128, 32 * ks, 64 * wn + 16 * ni, lane);
#pragma unroll
            for (int mi = 0; mi < 2; ++mi)
#pragma unroll
                for (int ni = 0; ni < 4; ++ni) acc[mi][ni] = MFMA16(af[mi], bfr[ni], acc[mi][ni]);
            if (wm == 0) {
#pragma unroll
                for (int ni = 0; ni < 4; ++ni) nacc[ni] = MFMA16(ones, bfr[ni], nacc[ni]); }
        }
        bf16_t* kvt = kv + (size_t)item * 16384;
#pragma unroll
        for (int mi = 0; mi < 2; ++mi)
#pragma unroll
            for (int r = 0; r < 4; ++r) { const int e = 32 * wm + 16 * mi + 4 * (lane >> 4) + r;
#pragma unroll
                for (int ni = 0; ni < 4; ++ni) kvt[e * 128 + 64 * wn + 16 * ni + (lane & 15)] = f2bf(acc[mi][ni][r]); }
        if (wm == 0 && lane < 16) {
#pragma unroll
            for (int ni = 0; ni < 4; ++ni) nloc[(size_t)item * 128 + 64 * wn + 16 * ni + lane] = nacc[ni][0]; }
        if (tid == 0) { mloc[item] = ml; gsum[item] = gtot; }
    }
}
__device__ __forceinline__ void ph_mlstm2(int WV_, bf16_t* kv, float* nloc, const float* mloc, const float* gsum, float* ms, const Items it) {
    const int tid = otid();
    float xn[16];
#define M2_LOAD(it_, dst) { const int bh_ = (it_) / 33, blk_ = (it_) % 33; \
        if (blk_ == 32) { _Pragma("unroll") for (int c = 0; c < 16; ++c) dst[c] = (tid < 128) ? nloc[(size_t)bh_ * 16 * 128 + tid + c * 128] : 0.f; } \
        else { const bf16_t* base_ = kv + (size_t)bh_ * 16 * 16384 + blk_ * NTHR + tid; _Pragma("unroll") for (int c = 0; c < 16; ++c) dst[c] = bf2f(base_[(size_t)c * 16384]); } }
    int item = it.first;
    if (it.count > 0) M2_LOAD(item, xn)
    for (int k_ = 0; k_ < it.count; ++k_, item += it.stride) {
        const int bh = item / 33, blk = item % 33;
        float dec[16], sc[16], x[16]; float m = 0.f;
#pragma unroll
        for (int c = 0; c < 16; ++c) x[c] = xn[c];
#pragma unroll
        for (int c = 0; c < 16; ++c) { const float G = gsum[bh * 16 + c], ML = mloc[bh * 16 + c]; const float mn = fmaxf(G + m, ML); dec[c] = fexp(G + m - mn); sc[c] = fexp(ML - mn);
            if (blk == 32 && tid == 0) ms[bh * 16 + c] = m;
            m = mn; }
        const int nitem = item + it.stride;
        if (k_ + 1 < it.count) M2_LOAD(nitem, xn)
        if (blk == 32) {
            if (tid < 128) { float* base = nloc + (size_t)bh * 16 * 128 + tid;
                float C = 0.f;
#pragma unroll
                for (int c = 0; c < 16; ++c) { base[c * 128] = C; C = dec[c] * C + sc[c] * x[c]; } }
        } else {
            bf16_t* base = kv + (size_t)bh * 16 * 16384 + blk * NTHR + tid;
            float C = 0.f;
#pragma unroll
            for (int c = 0; c < 16; ++c) { base[(size_t)c * 16384] = f2bf(C); C = dec[c] * C + sc[c] * x[c]; }
        }
    }
#undef M2_LOAD
}
__device__ __forceinline__ void ph_mlstm3(int WV_, unsigned char* lds, const bf16_t* z, const float* gates, const float* bif, const float* convw, const float* convb,
                                          const bf16_t* kv, const float* nst, const float* ms, const float* hng, bf16_t* cat, const Items it) {
    const int tid = otid(), lane = tid & 63, wave = __builtin_amdgcn_readfirstlane(tid >> 6), wm = wave >> 1, wn = wave & 1;
    unsigned char* Ql = lds; unsigned char* Kl = lds + TILE128; unsigned char* Cl = lds + 2 * TILE128; unsigned char* Vl = lds + 3 * TILE128;
    float* fa = (float*)(lds + 4 * TILE128);
    float* bcum = fa; float* uu = fa + 128; float* mt = fa + 256; float* iw = fa + 384; float* rowsum = fa + 512; float* rowss = fa + 640; float* nsv = fa + 768; float* qn = fa + 896; float* cf = fa + 1024; float* rf = fa + 1152;
    float* cwl = fa + 1280;
    int hst = -1;
    for (int k_ = 0, item = it.first; k_ < it.count; ++k_, item += it.stride) {
        const int c = item & 15, h = (item >> 4) & 3, b = item >> 6; const size_t tok0 = (size_t)b * SEQ + c * 128;
        const float msv = ms[item];
        __syncthreads();
        if (h != hst) { conv_stage_weights(cwl, convw, convb, h, 0, 2, tid); hst = h; __syncthreads(); }
        float gf0 = 0.f, gf1 = 0.f, gi0 = 0.f, gi1 = 0.f; f32x2 ns2 = (f32x2){0.f, 0.f};
        if (wave == 0) { const float* gp = gates + (tok0 + 2 * lane) * 8; gf0 = gp[4 + h]; gf1 = gp[12 + h]; gi0 = gp[h]; gi1 = gp[8 + h]; ns2 = *(const f32x2*)(nst + (size_t)item * 128 + 2 * lane); }
        { const int l = tid >> 2, q = tid & 3; u32x4 rq[4][4];
          conv_load(z + (tok0 + l) * ODD_N + h * 128 + q * 32, c * 128 + l, rq);
          conv_finish<128>(rq, c * 128 + l, cwl + q * 32, cwl + 1024 + q * 32, 1.f, Ql + l * LD128 + q * 64);
          __builtin_amdgcn_sched_barrier(0);
          conv_load(z + (tok0 + l) * ODD_N + 512 + h * 128 + q * 32, c * 128 + l, rq);
          conv_finish<128>(rq, c * 128 + l, cwl + 512 + q * 32, cwl + 1024 + 128 + q * 32, 0.08838834764831845f, Kl + l * LD128 + q * 64);
          __builtin_amdgcn_sched_barrier(0); }
        stage_tile(Cl, LD128, kv + (size_t)item * 16384, 128, 128, 128, tid);
        stage_tile(Vl, LD128, z + tok0 * ODD_N + 1024 + h * 128, ODD_N, 128, 128, tid);
        if (wave == 0) {
            const float bf_ = bif[4 + h], bi_ = bif[h];
            const float lf0 = logsigmoidf_(gf0 + bf_), lf1 = logsigmoidf_(gf1 + bf_);
            const float S = wave_scan_add(lf0 + lf1); const float b0 = S - lf1, b1 = S;
            const float u0 = gi0 + bi_ - b0, u1 = gi1 + bi_ - b1;
            const float M = wave_scan_max(fmaxf(u0, u1)); const float E = wave_shr1(-3.0e38f, M);
            const float m0 = b0 + fmaxf(msv, fmaxf(E, u0)), m1 = b1 + fmaxf(msv, M);
            *(f32x2*)(mt + 2 * lane) = (f32x2){m0, m1}; *(f32x2*)(iw + 2 * lane) = (f32x2){fexp(b0 + msv - m0), fexp(b1 + msv - m1)};
            *(f32x2*)(cf + 2 * lane) = (f32x2){fexp(u0), fexp(u1)}; *(f32x2*)(rf + 2 * lane) = (f32x2){fexp(b0 - m0), fexp(b1 - m1)};
            *(f32x2*)(rowsum + 2 * lane) = (f32x2){0.f, 0.f}; *(f32x2*)(rowss + 2 * lane) = (f32x2){0.f, 0.f}; *(f32x2*)(nsv + 2 * lane) = ns2;
        }
        __syncthreads();
        { const int r_ = tid >> 2, p_ = tid & 3; const unsigned char* row = Ql + r_ * LD128 + p_ * 64; const float* vec = nsv + p_ * 32; float sd = 0.f;
#pragma unroll
          for (int cc = 0; cc < 4; ++cc) { float f[8]; unpack8(*(const u32x4*)(row + 16 * cc), f); const f32x4 a4 = ((const f32x4*)vec)[2 * cc], b4 = ((const f32x4*)vec)[2 * cc + 1];
              sd += (f[0] * a4[0] + f[1] * a4[1]) + (f[2] * a4[2] + f[3] * a4[3]) + (f[4] * b4[0] + f[5] * b4[1]) + (f[6] * b4[2] + f[7] * b4[3]); }
          sd = sum4(sd); if (p_ == 0) qn[r_] = sd; }
        f32x4 sa[2][4];
#pragma unroll
        for (int mi = 0; mi < 2; ++mi)
#pragma unroll
            for (int ni = 0; ni < 4; ++ni) sa[mi][ni] = (f32x4){0.f, 0.f, 0.f, 0.f};
#pragma unroll
        for (int ks = 0; ks < 4; ++ks) {
            bf16x8 af[2], bfr[4];
#pragma unroll
            for (int mi = 0; mi < 2; ++mi) af[mi] = frag_row((const LAS unsigned char*)Ql, LD128, 32 * wm + 16 * mi, 32 * ks, lane);
#pragma unroll
            for (int ni = 0; ni < 4; ++ni) bfr[ni] = frag_row((const LAS unsigned char*)Kl, LD128, 64 * wn + 16 * ni, 32 * ks, lane);
#pragma unroll
            for (int mi = 0; mi < 2; ++mi)
#pragma unroll
                for (int ni = 0; ni < 4; ++ni) sa[mi][ni] = MFMA16(af[mi], bfr[ni], sa[mi][ni]);
        }
        __syncthreads();
#pragma unroll
        for (int mi = 0; mi < 2; ++mi)
#pragma unroll
            for (int r = 0; r < 4; ++r) { const int t = 32 * wm + 16 * mi + 4 * (lane >> 4) + r; const float rt = rf[t]; float rs = 0.f;
                float us[4];
#pragma unroll
                for (int ni = 0; ni < 4; ++ni) us[ni] = cf[64 * wn + 16 * ni + (lane & 15)];
#pragma unroll
                for (int ni = 0; ni < 4; ++ni) { const int s = 64 * wn + 16 * ni + (lane & 15);
                    const float w = (s <= t) ? rt * us[ni] : 0.f; const float v = sa[mi][ni][r] * w; rs += v;
                    *(bf16_t*)(Kl + t * LD128 + s * 2) = f2bf(v); }
                rs = sum16(rs); if ((lane & 15) == 0) atomicAdd(&rowsum[t], rs); }
        __syncthreads();
        f32x4 ao[2][4], ai[2][4];
#pragma unroll
        for (int mi = 0; mi < 2; ++mi)
#pragma unroll
            for (int ni = 0; ni < 4; ++ni) { ao[mi][ni] = (f32x4){0.f, 0.f, 0.f, 0.f}; ai[mi][ni] = (f32x4){0.f, 0.f, 0.f, 0.f}; }
#pragma unroll
        for (int ks = 0; ks < 4; ++ks) {
            bf16x8 af[2], bfr[4];
#pragma unroll
            for (int mi = 0; mi < 2; ++mi) af[mi] = frag_row((const LAS unsigned char*)Kl, LD128, 32 * wm + 16 * mi, 32 * ks, lane);
#pragma unroll
            for (int ni = 0; ni < 4; ++ni) bfr[ni] = frag_tr((const LAS unsigned char*)Vl, LD128, 32 * ks, 64 * wn + 16 * ni, lane);
#pragma unroll
            for (int mi = 0; mi < 2; ++mi)
#pragma unroll
                for (int ni = 0; ni < 4; ++ni) ao[mi][ni] = MFMA16(af[mi], bfr[ni], ao[mi][ni]);
#pragma unroll
            for (int mi = 0; mi < 2; ++mi) af[mi] = frag_row((const LAS unsigned char*)Ql, LD128, 32 * wm + 16 * mi, 32 * ks, lane);
#pragma unroll
            for (int ni = 0; ni < 4; ++ni) bfr[ni] = frag_row((const LAS unsigned char*)Cl, LD128, 64 * wn + 16 * ni, 32 * ks, lane);
#pragma unroll
            for (int mi = 0; mi < 2; ++mi)
#pragma unroll
                for (int ni = 0; ni < 4; ++ni) ai[mi][ni] = MFMA16(af[mi], bfr[ni], ai[mi][ni]);
        }
        float ogv[2][4][4], hgv[4];
#pragma unroll
        for (int ni = 0; ni < 4; ++ni) hgv[ni] = hng[h * 128 + 64 * wn + 16 * ni + (lane & 15)];
#pragma unroll
        for (int mi = 0; mi < 2; ++mi)
#pragma unroll
            for (int r = 0; r < 4; ++r) { const int t = 32 * wm + 16 * mi + 4 * (lane >> 4) + r;
#pragma unroll
                for (int ni = 0; ni < 4; ++ni) ogv[mi][r][ni] = bf2f(z[(tok0 + t) * ODD_N + 1536 + h * 128 + 64 * wn + 16 * ni + (lane & 15)]); }
#pragma unroll
        for (int mi = 0; mi < 2; ++mi)
#pragma unroll
            for (int r = 0; r < 4; ++r) { const int t = 32 * wm + 16 * mi + 4 * (lane >> 4) + r;
                const float w = iw[t], den = w * qn[t] + rowsum[t], dd = fmaxf(fabsf(den), fexp(-mt[t])), inv = 1.f / dd; float ss = 0.f;
#pragma unroll
                for (int ni = 0; ni < 4; ++ni) { const float o = (w * ai[mi][ni][r] + ao[mi][ni][r]) * inv; ao[mi][ni][r] = o; ss += o * o; }
                ss = sum16(ss); if ((lane & 15) == 0) atomicAdd(&rowss[t], ss); }
        __syncthreads();
#pragma unroll
        for (int mi = 0; mi < 2; ++mi)
#pragma unroll
            for (int r = 0; r < 4; ++r) { const int t = 32 * wm + 16 * mi + 4 * (lane >> 4) + r; const float rstd = 1.f / sqrtf(rowss[t] * (1.f / 128.f) + EPS);
#pragma unroll
                for (int ni = 0; ni < 4; ++ni) { const int e = 64 * wn + 16 * ni + (lane & 15);
                    cat[(tok0 + t) * 1024 + h * 128 + e] = f2bf(ao[mi][ni][r] * rstd * hgv[ni] * sigmoidf_(ogv[mi][r][ni])); } }
    }
}

__device__ __forceinline__ void ph_moba_prep(int WV_, unsigned char* lds, bf16_t* z, const float* qg, const float* kg, float* ksum, const Items it) {
    const int tid = otid(), lane = tid & 63, wave = __builtin_amdgcn_readfirstlane(tid >> 6);
    float* wsum = (float*)lds;
    float* gl = wsum + 8 * 128;
    if (tid < 256) gl[tid] = (tid < 128) ? qg[tid] : kg[tid - 128];
    for (int k_ = 0, item = it.first; k_ < it.count; ++k_, item += it.stride) {
        const int nb = item & 7, h = (item >> 3) & 3, b = item >> 5;
        const int tk = tid >> 1, hf = tid & 1, pos = nb * 256 + tk; const size_t tok = (size_t)b * SEQ + pos;
        bf16_t* qp = z + tok * ODD_N + 2048 + h * 128 + hf * 64; bf16_t* kp = qp + 512;
        float sq = 0.f, sk = 0.f;
#pragma unroll
        for (int c = 0; c < 8; ++c) { float f[8]; unpack8(*(const u32x4*)(qp + 8 * c), f);
#pragma unroll
            for (int j = 0; j < 8; ++j) sq += f[j] * f[j];
            unpack8(*(const u32x4*)(kp + 8 * c), f);
#pragma unroll
            for (int j = 0; j < 8; ++j) sk += f[j] * f[j]; }
        sq += xor1f(sq); sk += xor1f(sk);
        const float rq = (1.f / sqrtf(sq * (1.f / 128.f) + EPS)) * (0.08838834764831845f * LOG2E), rk = 1.f / sqrtf(sk * (1.f / 128.f) + EPS);
        __syncthreads();
        u32x4 nq = *(const u32x4*)qp, nk = *(const u32x4*)kp;
#pragma unroll 1
        for (int c = 0; c < 8; ++c) {
            float fq[8], fk[8]; unpack8(nq, fq); unpack8(nk, fk);
            if (c + 1 < 8) { nq = *(const u32x4*)(qp + 8 * (c + 1)); nk = *(const u32x4*)(kp + 8 * (c + 1)); }
            const f32x4 gq0 = *(const f32x4*)(gl + hf * 64 + 8 * c), gq1 = *(const f32x4*)(gl + hf * 64 + 8 * c + 4), gk0 = *(const f32x4*)(gl + 128 + hf * 64 + 8 * c), gk1 = *(const f32x4*)(gl + 128 + hf * 64 + 8 * c + 4);
            const float gqv[8] = {gq0.x, gq0.y, gq0.z, gq0.w, gq1.x, gq1.y, gq1.z, gq1.w}, gkv[8] = {gk0.x, gk0.y, gk0.z, gk0.w, gk1.x, gk1.y, gk1.z, gk1.w};
            float ks8[8];
#pragma unroll
            for (int jj = 0; jj < 8; ++jj) {
                const int i = 8 * c + jj;
                const float a = fq[jj] * rq * gqv[jj], bq = fk[jj] * rk * gkv[jj];
                const float ao = xor1f(a), bo = xor1f(bq);
                const float invf = fexp2(-(float)i * (13.287712379549449f / 64.f));
                float rev = (float)pos * invf * 0.15915494309189535f; rev -= floorf(rev);
                const float sn = __builtin_amdgcn_sinf(rev), cs = __builtin_amdgcn_cosf(rev);
                fq[jj] = hf ? (ao * sn + a * cs) : (a * cs - ao * sn);
                float kv = hf ? (bo * sn + bq * cs) : (bq * cs - bo * sn);
                fk[jj] = kv;
                kv += xor2f(kv); kv += dppf<0x124>(kv); kv += dppf<0x128>(kv); kv = sum_rows(kv);
                ks8[jj] = kv;
            }
            if (lane < 2) { *(f32x4*)(wsum + wave * 128 + hf * 64 + 8 * c) = (f32x4){ks8[0], ks8[1], ks8[2], ks8[3]}; *(f32x4*)(wsum + wave * 128 + hf * 64 + 8 * c + 4) = (f32x4){ks8[4], ks8[5], ks8[6], ks8[7]}; }
            *(u32x4*)(qp + 8 * c) = pack8(fq);
            *(u32x4*)(kp + 8 * c) = pack8(fk);
        }
        __syncthreads();
        if (tid < 128) { float s = 0.f;
#pragma unroll
            for (int w = 0; w < 8; ++w) s += wsum[w * 128 + tid];
            ksum[(size_t)item * 128 + tid] = s; }
    }
}

template <int DH>
struct AttnState { f32x4 o[DH / 16]; f32x4 lv; };
__device__ __forceinline__ bf16x8 frag_trp(const LAS unsigned char* base, int ld, int k0, int col0, int lane) {
    const int g = lane >> 4, q = (lane & 15) >> 2, p = lane & 3;
    const LAS unsigned char* a = base + (k0 + 4 * g + q) * ld + (col0 + 4 * p) * 2;
    const s16x4 v0 = __builtin_amdgcn_ds_read_tr16_b64_v4i16((LAS s16x4*)a);
    const s16x4 v1 = __builtin_amdgcn_ds_read_tr16_b64_v4i16((LAS s16x4*)(a + 16 * ld));
    return (bf16x8){v0[0], v0[1], v0[2], v0[3], v1[0], v1[1], v1[2], v1[3]};
}
struct MobaMask { bool own, rowsel; int k0, qpos; };
template <int NKT>
__device__ __forceinline__ void moba_p(const f32x4 (&sv)[NKT], const MobaMask& v, int g, bf16x8 (&pf)[NKT / 2]) {
    if (v.own) {
#pragma unroll
        for (int ks = 0; ks < NKT / 2; ++ks) { float p[8];
#pragma unroll
            for (int j = 0; j < 8; ++j) { const int kt = 2 * ks + (j >> 2), r = j & 3; const float e = fexp2(sv[kt][r]); p[j] = (v.k0 + 16 * kt + 4 * g + r <= v.qpos) ? e : 0.f; }
            const u32x4 w = pack8(p); pf[ks] = __builtin_bit_cast(bf16x8, w); }
    } else {
#pragma unroll
        for (int ks = 0; ks < NKT / 2; ++ks) { float p[8];
#pragma unroll
            for (int j = 0; j < 8; ++j) p[j] = fexp2(sv[2 * ks + (j >> 2)][j & 3]);
            u32x4 w = pack8(p); if (!v.rowsel) w = (u32x4){0u, 0u, 0u, 0u};
            pf[ks] = __builtin_bit_cast(bf16x8, w); }
    }
}
template <int DH, int NKT>
__device__ __forceinline__ void moba_S(f32x4 (&sA)[NKT], f32x4 (&sB)[NKT], const bf16x8 (&qaA)[DH / 32], const bf16x8 (&qaB)[DH / 32], bool actA, const unsigned char* Kl, int ldk, int lane) {
#pragma unroll
    for (int kt = 0; kt < NKT; ++kt) { sA[kt] = (f32x4){0.f, 0.f, 0.f, 0.f}; sB[kt] = (f32x4){0.f, 0.f, 0.f, 0.f}; }
    if (actA) {
#pragma unroll
        for (int ks = 0; ks < DH / 32; ++ks) {
#pragma unroll
            for (int kt = 0; kt < NKT; ++kt) { const bf16x8 kf = frag_row((const LAS unsigned char*)Kl, ldk, 16 * kt, 32 * ks, lane); sA[kt] = MFMA16(kf, qaA[ks], sA[kt]); sB[kt] = MFMA16(kf, qaB[ks], sB[kt]); }
            if ((ks & 1) == 1) __builtin_amdgcn_sched_barrier(0); }
    } else {
#pragma unroll
        for (int ks = 0; ks < DH / 32; ++ks) {
#pragma unroll
            for (int kt = 0; kt < NKT; ++kt) sB[kt] = MFMA16(frag_row((const LAS unsigned char*)Kl, ldk, 16 * kt, 32 * ks, lane), qaB[ks], sB[kt]);
            if ((ks & 1) == 1) __builtin_amdgcn_sched_barrier(0); }
    }
}
template <int NKT>
__device__ __forceinline__ void moba_P2(const f32x4 (&sA)[NKT], const f32x4 (&sB)[NKT], bool actA, const MobaMask& validA, const MobaMask& validB, int lane, bf16x8 (&pA)[NKT / 2], bf16x8 (&pB)[NKT / 2]) {
    const int g = lane >> 4;
    moba_p<NKT>(sB, validB, g, pB);
    if (actA) moba_p<NKT>(sA, validA, g, pA);
}
template <int DH, int NKT>
__device__ __forceinline__ void moba_PV(AttnState<DH>& sa_, AttnState<DH>& sb_, const bf16x8 (&pA)[NKT / 2], const bf16x8 (&pB)[NKT / 2], bool actA, const unsigned char* Vl, int ldk, int lane) {
    const bf16x8 ones = __builtin_bit_cast(bf16x8, (u32x4){0x3F803F80u, 0x3F803F80u, 0x3F803F80u, 0x3F803F80u});
    if (actA) {
#pragma unroll
        for (int ks = 0; ks < NKT / 2; ++ks) { sa_.lv = MFMA16(ones, pA[ks], sa_.lv); sb_.lv = MFMA16(ones, pB[ks], sb_.lv); }
#pragma unroll
        for (int ne = 0; ne < DH / 16; ++ne) {
#pragma unroll
            for (int ks = 0; ks < NKT / 2; ++ks) { const bf16x8 vf = frag_trp((const LAS unsigned char*)Vl, ldk, 32 * ks, 16 * ne, lane); sa_.o[ne] = MFMA16(vf, pA[ks], sa_.o[ne]); sb_.o[ne] = MFMA16(vf, pB[ks], sb_.o[ne]); }
            if ((ne & 3) == 3) __builtin_amdgcn_sched_barrier(0); }
    } else {
#pragma unroll
        for (int ks = 0; ks < NKT / 2; ++ks) sb_.lv = MFMA16(ones, pB[ks], sb_.lv);
#pragma unroll
        for (int ne = 0; ne < DH / 16; ++ne) {
#pragma unroll
            for (int ks = 0; ks < NKT / 2; ++ks) sb_.o[ne] = MFMA16(frag_trp((const LAS unsigned char*)Vl, ldk, 32 * ks, 16 * ne, lane), pB[ks], sb_.o[ne]);
            if ((ne & 3) == 3) __builtin_amdgcn_sched_barrier(0); }
    }
}

__device__ __forceinline__ void moba_gate2(int tid, int obA, int obB, const unsigned char* QlA, const unsigned char* QlB, const float* kmean, unsigned* selA, unsigned* selB) {
    const int set = tid >> 8, row = (tid & 255) >> 1, hf = tid & 1; const int ob = set ? obB : obA; const unsigned char* Ql = set ? QlB : QlA; unsigned* sel = set ? selB : selA;
    float gt[7];
#pragma unroll
    for (int n = 0; n < 7; ++n) gt[n] = 0.f;
#pragma unroll 2
    for (int c = 0; c < 8; ++c) { float f[8]; unpack8(*(const u32x4*)(Ql + row * 288 + hf * 128 + 16 * c), f);
#pragma unroll
        for (int n = 0; n < 7; ++n) { const f32x4 a = *(const f32x4*)(kmean + n * 128 + hf * 64 + 8 * c), b2 = *(const f32x4*)(kmean + n * 128 + hf * 64 + 8 * c + 4);
            gt[n] += (f[0] * a[0] + f[1] * a[1]) + (f[2] * a[2] + f[3] * a[3]) + (f[4] * b2[0] + f[5] * b2[1]) + (f[6] * b2[2] + f[7] * b2[3]); } }
#pragma unroll
    for (int n = 0; n < 7; ++n) gt[n] += xor1f(gt[n]);
    if (hf == 0) {
        unsigned mask = 0u;
#pragma unroll
        for (int k = 0; k < 3; ++k) { int bi = -1; float bv = -3.0e38f;
#pragma unroll
            for (int n = 0; n < 7; ++n) if (n < ob && !((mask >> n) & 1u) && gt[n] > bv) { bv = gt[n]; bi = n; }
            if (bi >= 0) mask |= 1u << bi; }
        sel[row] = mask; if (mask) atomicOr(&sel[128], mask);
    }
}
constexpr int LDM = 288;
__device__ __forceinline__ void ph_moba_attn(int WV_, unsigned char* lds, const bf16_t* z, const float* ksum, bf16_t* cat, const Items it) {
    const int tid = otid(), lane = tid & 63, wave = __builtin_amdgcn_readfirstlane(tid >> 6);
    unsigned char* Ql = lds; unsigned char* Kb = lds + (128 * LDM); unsigned char* Vb = Kb + 2 * 64 * LDM;
    float* kmean = (float*)(Vb + 2 * 64 * LDM);
    unsigned* selA = (unsigned*)(kmean + 8 * 128);
    unsigned* selB = selA + 132;
    for (int k_ = 0, item = it.first; k_ < it.count; ++k_, item += it.stride) {
        const int p = item & 7, h = (item >> 3) & 3, b = item >> 5; const size_t tokb = (size_t)b * SEQ;
        const int qtA = p, qtB = 15 - p, obA = qtA >> 1, obB = qtB >> 1, qA0 = qtA * 128, qB0 = qtB * 128;
        __syncthreads();
        unsigned char* QlB = Kb;
        { u32x4 ra[4], rb[4];
#pragma unroll
          for (int jj = 0; jj < 4; ++jj) { const int i = tid + NTHR * jj; ra[jj] = *(const u32x4*)(z + (tokb + qA0 + (i >> 4)) * ODD_N + 2048 + h * 128 + (i & 15) * 8); rb[jj] = *(const u32x4*)(z + (tokb + qB0 + (i >> 4)) * ODD_N + 2048 + h * 128 + (i & 15) * 8); }
          for (int i = tid; i < 8 * 128; i += NTHR) kmean[i] = ksum[((size_t)(b * 4 + h) * 8) * 128 + i] * (1.f / 256.f);
          if (tid == 0) { selA[128] = 0u; selB[128] = 0u; }
#pragma unroll
          for (int jj = 0; jj < 4; ++jj) { const int i = tid + NTHR * jj; *(u32x4*)(Ql + (i >> 4) * LDM + (i & 15) * 16) = ra[jj]; *(u32x4*)(QlB + (i >> 4) * LDM + (i & 15) * 16) = rb[jj]; } }
        __syncthreads();
        moba_gate2(tid, obA, obB, Ql, QlB, kmean, selA, selB);
        bf16x8 qaA[4], qaB[4];
#pragma unroll
        for (int ks = 0; ks < 4; ++ks) { qaA[ks] = frag_row((const LAS unsigned char*)Ql, LDM, 16 * wave, 32 * ks, lane); qaB[ks] = frag_row((const LAS unsigned char*)QlB, LDM, 16 * wave, 32 * ks, lane); }
        __syncthreads();
        const unsigned anyA = selA[128], anyB = selB[128];
        const unsigned selrA = selA[16 * wave + (lane & 15)], selrB = selB[16 * wave + (lane & 15)];
        AttnState<128> stA, stB;
#pragma unroll
        for (int ne = 0; ne < 8; ++ne) { stA.o[ne] = (f32x4){0.f, 0.f, 0.f, 0.f}; stB.o[ne] = (f32x4){0.f, 0.f, 0.f, 0.f}; }
        stA.lv = (f32x4){0.f, 0.f, 0.f, 0.f}; stB.lv = (f32x4){0.f, 0.f, 0.f, 0.f};
        const int ntA = obA * 4 + (qA0 + 128 - 256 * obA) / 64, ntB = obB * 4 + (qB0 + 128 - 256 * obB) / 64;
#define MB_NEED(t_, ob_, nt_, any_) ((t_) < (nt_) && (((t_) >> 2) == (ob_) || (((any_) >> ((t_) >> 2)) & 1u)))
#define MB_SKIP(t_) while ((t_) < ntB && !MB_NEED(t_, obA, ntA, anyA) && !MB_NEED(t_, obB, ntB, anyB)) (t_) += 1
        const int pr = tid >> 4, pc = tid & 15;
        const bf16_t* kbase = z + tokb * ODD_N + 2560 + h * 128 + pc * 8;
        u32x4 ka0, ka1, va0, va1, kb0, kb1, vb0, vb1;
#define MB_LOAD(t_, k0_, k1_, v0_, v1_) { const bf16_t* p0 = kbase + (size_t)((t_) * 64 + pr) * ODD_N; k0_ = *(const u32x4*)p0; k1_ = *(const u32x4*)(p0 + (size_t)32 * ODD_N); v0_ = *(const u32x4*)(p0 + 512); v1_ = *(const u32x4*)(p0 + (size_t)32 * ODD_N + 512); }
        int ti = 0; MB_SKIP(ti);
        int t1 = ti + 1; MB_SKIP(t1);
        if (ti < ntB) MB_LOAD(ti, ka0, ka1, va0, va1)
        if (t1 < ntB) MB_LOAD(t1, kb0, kb1, vb0, vb1)
        bf16x8 pA[2], pB[2];
#define MB_STEP(k0_, k1_, v0_, v1_, buf_) { \
            const int n = ti >> 2, k0 = ti * 64;                \
            unsigned char* Kl = Kb + (buf_) * 64 * LDM; unsigned char* Vl = Vb + (buf_) * 64 * LDM; \
            *(u32x4*)(Kl + pr * LDM + pc * 16) = k0_; *(u32x4*)(Kl + (pr + 32) * LDM + pc * 16) = k1_; \
            *(u32x4*)(Vl + pr * LDM + pc * 16) = v0_; *(u32x4*)(Vl + (pr + 32) * LDM + pc * 16) = v1_; \
            int t2 = t1 + 1; MB_SKIP(t2); \
            if (t2 < ntB) MB_LOAD(t2, k0_, k1_, v0_, v1_) \
            __syncthreads();                                     \
            const bool actA = MB_NEED(ti, obA, ntA, anyA); \
            const bool ownA = (n == obA), ownB = (n == obB); const int qposA = qA0 + 16 * wave + (lane & 15), qposB = qB0 + 16 * wave + (lane & 15); \
            const bool rsA = ((selrA >> n) & 1u) != 0u, rsB = ((selrB >> n) & 1u) != 0u; \
            f32x4 sA[4], sB[4]; \
            moba_S<128, 4>(sA, sB, qaA, qaB, actA, Kl, LDM, lane); \
            moba_P2<4>(sA, sB, actA, MobaMask{ownA, rsA, k0, qposA}, MobaMask{ownB, rsB, k0, qposB}, lane, pA, pB); \
            moba_PV<128, 4>(stA, stB, pA, pB, actA, Vl, LDM, lane); \
            ti = t1; t1 = t2; }
        while (ti < ntB) {
            MB_STEP(ka0, ka1, va0, va1, 0)
            if (ti >= ntB) break;
            MB_STEP(kb0, kb1, vb0, vb1, 1)
        }
#undef MB_STEP
#undef MB_LOAD
#undef MB_SKIP
#undef MB_NEED
        { const float invA = 1.f / stA.lv[0], invB = 1.f / stB.lv[0]; const size_t tokA = tokb + qA0 + 16 * wave + (lane & 15), tokB = tokb + qB0 + 16 * wave + (lane & 15);
#pragma unroll
          for (int ne = 0; ne < 8; ++ne) { u32x2 w; w.x = pk2(stA.o[ne][0] * invA, stA.o[ne][1] * invA); w.y = pk2(stA.o[ne][2] * invA, stA.o[ne][3] * invA);
              *(u32x2*)(cat + tokA * 1024 + 512 + h * 128 + 16 * ne + 4 * (lane >> 4)) = w;
              w.x = pk2(stB.o[ne][0] * invB, stB.o[ne][1] * invB); w.y = pk2(stB.o[ne][2] * invB, stB.o[ne][3] * invB);
              *(u32x2*)(cat + tokB * 1024 + 512 + h * 128 + 16 * ne + 4 * (lane >> 4)) = w; } }
    }
}

__device__ __forceinline__ void ph_khat(int WV_, const bf16_t* mkv, const float* kg, const float* qg, bf16_t* khat, int wg, int nwg, int jlo, int jhi) {
    const int tid = otid(), lane = tid & 63, wave = __builtin_amdgcn_readfirstlane(tid >> 6);
    const f32x4 g4 = *(const f32x4*)(kg + 4 * lane), q4 = *(const f32x4*)(qg + 4 * lane);
    const int jstride = nwg * 8;
    for (int job0 = jlo + wg * 8 + wave; job0 < jhi; job0 += 4 * jstride) {
        u32x2 wv[4];
#pragma unroll
        for (int k = 0; k < 4; ++k) { const int job = job0 + k * jstride; wv[k] = (u32x2){0u, 0u}; if (job < jhi) wv[k] = *(const u32x2*)(mkv + (size_t)(job >> 2) * 2048 + (job & 3) * 256 + 4 * lane); }
#pragma unroll
        for (int k = 0; k < 4; ++k) { const int job = job0 + k * jstride; const int row = job >> 2, hh = job & 3; const u32x2 w = wv[k];
            const float x0 = bflo(w.x), x1 = bfhi(w.x), x2 = bflo(w.y), x3 = bfhi(w.y);
            const float rk = 1.f / sqrtf(wave_sum((x0 * x0 + x1 * x1) + (x2 * x2 + x3 * x3)) * (1.f / 256.f) + EPS);
            u32x2 o; o.x = pk2(x0 * rk * g4.x * q4.x, x1 * rk * g4.y * q4.y); o.y = pk2(x2 * rk * g4.z * q4.z, x3 * rk * g4.w * q4.w);
            if (job < jhi) *(u32x2*)(khat + (size_t)row * 1024 + hh * 256 + 4 * lane) = o; }
    }
}

constexpr int LD256 = 544;
__device__ __forceinline__ void ph_xattn(int WV_, unsigned char* lds, const bf16_t* q, const bf16_t* mkv, const bf16_t* khat, bf16_t* o, int G, int bx) {
    const int tid = otid(), lane = tid & 63, wave = __builtin_amdgcn_readfirstlane(tid >> 6);
    pg8::StaticOrder<T, 1024> SO; SO.init(G, bx);
    for (int it = 0; ; ++it) {
        pg8::Unit un; if (!SO.next(it, un)) break;
        const int h = un.pn, b = un.pm >> 3; const size_t tok0 = (size_t)un.pm * 256 + 32 * wave;
        bf16x8 qa[2][8]; float sc[2];
#pragma unroll
        for (int rt = 0; rt < 2; ++rt) { float ssq = 0.f;
#pragma unroll
            for (int ks = 0; ks < 8; ++ks) { const u32x4 v = *(const u32x4*)(q + (tok0 + 16 * rt + (lane & 15)) * 1024 + h * 256 + 32 * ks + 8 * (lane >> 4));
                float f[8]; unpack8(v, f);
#pragma unroll
                for (int j = 0; j < 8; ++j) ssq += f[j] * f[j];
                qa[rt][ks] = __builtin_bit_cast(bf16x8, v); }
            ssq = sum_rows(ssq);
            sc[rt] = (1.f / sqrtf(ssq * (1.f / 256.f) + EPS)) * (0.0625f * LOG2E); }
        const int m = tid >> 5, part = tid & 31;
        const bf16_t* ksrc = khat + ((size_t)b * NMEM + m) * 1024 + h * 256 + part * 8;
        const bf16_t* vsrc = mkv + ((size_t)b * NMEM + m) * 2048 + 1024 + h * 256 + part * 8;
        u32x4 sr[2][4];
#define XA_SRC(t_, c_) (((t_) < 4) ? ksrc + (size_t)((t_) * 64 + 16 * (c_)) * 1024 : vsrc + (size_t)(((t_) - 4) * 64 + 16 * (c_)) * 2048)
#pragma unroll
        for (int c = 0; c < 4; ++c) { sr[0][c] = *(const u32x4*)XA_SRC(0, c); sr[1][c] = *(const u32x4*)XA_SRC(1, c); }
        bf16x8 pb[2][8]; float l0 = 0.f, l1 = 0.f;
        f32x4 oa[2][16];
        __syncthreads();
#pragma unroll
        for (int ti = 0; ti < 8; ++ti) {
            unsigned char* Tl = lds + (ti & 1) * 64 * LD256;
#pragma unroll
            for (int c = 0; c < 4; ++c) *(u32x4*)(Tl + (m + 16 * c) * LD256 + part * 16) = sr[ti & 1][c];
            if (ti + 2 < 8) {
#pragma unroll
                for (int c = 0; c < 4; ++c) sr[ti & 1][c] = *(const u32x4*)XA_SRC(ti + 2, c); }
            __syncthreads();
            if (ti < 4) {
                f32x4 s0[4], s1[4];
#pragma unroll
                for (int kt = 0; kt < 4; ++kt) { s0[kt] = (f32x4){0.f, 0.f, 0.f, 0.f}; s1[kt] = (f32x4){0.f, 0.f, 0.f, 0.f}; }
#pragma unroll
                for (int ks = 0; ks < 8; ++ks) {
#pragma unroll
                    for (int kt = 0; kt < 4; ++kt) { const bf16x8 kf = frag_row((const LAS unsigned char*)Tl, LD256, 16 * kt, 32 * ks, lane); s0[kt] = MFMA16(kf, qa[0][ks], s0[kt]); s1[kt] = MFMA16(kf, qa[1][ks], s1[kt]); }
                    if ((ks & 1) == 1) __builtin_amdgcn_sched_barrier(0); }
#pragma unroll
                for (int k2 = 0; k2 < 2; ++k2) { float p[8];
#pragma unroll
                    for (int j = 0; j < 8; ++j) { p[j] = fexp2(s0[2 * k2 + (j >> 2)][j & 3] * sc[0]); l0 += p[j]; }
                    u32x4 w = pack8(p); pb[0][2 * (ti & 3) + k2] = __builtin_bit_cast(bf16x8, w);
#pragma unroll
                    for (int j = 0; j < 8; ++j) { p[j] = fexp2(s1[2 * k2 + (j >> 2)][j & 3] * sc[1]); l1 += p[j]; }
                    w = pack8(p); pb[1][2 * (ti & 3) + k2] = __builtin_bit_cast(bf16x8, w); }
            } else {
#pragma unroll
                for (int ne = 0; ne < 16; ++ne) {
#pragma unroll
                    for (int k2 = 0; k2 < 2; ++k2) { const bf16x8 vf = frag_trp((const LAS unsigned char*)Tl, LD256, 32 * k2, 16 * ne, lane); const bool first = (ti == 4 && k2 == 0);
                        oa[0][ne] = MFMA16(vf, pb[0][2 * (ti & 3) + k2], first ? ((f32x4){0.f, 0.f, 0.f, 0.f}) : oa[0][ne]); oa[1][ne] = MFMA16(vf, pb[1][2 * (ti & 3) + k2], first ? ((f32x4){0.f, 0.f, 0.f, 0.f}) : oa[1][ne]); }
                    if ((ne & 3) == 3) __builtin_amdgcn_sched_barrier(0); }
            }
        }
#pragma unroll
        for (int rt = 0; rt < 2; ++rt) { const float inv = 1.f / sum_rows(rt ? l1 : l0); const size_t tok = tok0 + 16 * rt + (lane & 15);
#pragma unroll
            for (int ne = 0; ne < 16; ++ne) { u32x2 w; w.x = pk2(oa[rt][ne][0] * inv, oa[rt][ne][1] * inv); w.y = pk2(oa[rt][ne][2] * inv, oa[rt][ne][3] * inv);
                *(u32x2*)(o + tok * 1024 + h * 256 + 16 * ne + 4 * (lane >> 4)) = w; } }
#undef XA_SRC
    }
}


__global__ void __launch_bounds__(NTHR, 2) hybrid_fwd(Args a) {
    extern __shared__ __attribute__((aligned(16))) unsigned char lds[];
    const int WV_ = __builtin_amdgcn_readfirstlane(threadIdx.x >> 6);
    const int tid = threadIdx.x;
    volatile LAS unsigned* ctlw = (volatile LAS unsigned*)((LAS unsigned char*)lds + LDS_SCRATCH);
    if (tid < 64) ctlw[tid] = 0u;
    __syncthreads();
    XcdBarrier bar; bar.bar = (unsigned*)(a.ws + WS_CTL); bar.x = 0; bar.st = ctlw;
    if (a.hi - a.lo > 1) bar = xcd_barrier_post((unsigned*)(a.ws + WS_CTL), ctlw);
    if (tid == 0) { unsigned* ctl0 = (unsigned*)(a.ws + WS_CTL); if (xb_ld(&ctl0[GB_XCC(blockIdx.x & 255)]) == 0u) (void)xb_add(&ctl0[GB_XCC(blockIdx.x & 255)], xb_xcc_id() + 1u);
                    if (xb_xcc_id() != (blockIdx.x & 7u) || gridDim.x != 256u) (void)xb_add(&ctl0[XL_BAD], 1u); }
    int ph = 0;
    constexpr int CNT0 = __COUNTER__ + 1;
#define PH_BEGIN if (__builtin_amdgcn_readfirstlane((int)(ph >= arg_lohi(a, 0) && ph < arg_lohi(a, 1)))) { unsigned char* ws = opq(a.ws); float* h = opq(a.out); int oz_ = 0; asm volatile("" : "+s"(oz_)); const int G = (int)gridDim.x + oz_, bx = (int)blockIdx.x + oz_; const bool xm = (G == 256); (void)xm; (void)h; (void)G; (void)bx; \
        bf16_t* hb = (bf16_t*)(ws + WS_XN); bf16_t* cat = (bf16_t*)(ws + WS_CAT); unsigned char* big = ws + WS_BIG; float* ssb = (float*)(ws + WS_SS); (void)hb; (void)cat; (void)big; (void)ssb;
#define PH_END   if (__builtin_amdgcn_readfirstlane((int)(ph + 1 < arg_lohi(a, 1)))) { for (int rep_ = 0; rep_ < REP_BAR; ++rep_) xcd_barrier(bar); } } ph = __builtin_amdgcn_readfirstlane(ph + 1);
#define PH_END_XL(xl_) if (__builtin_amdgcn_readfirstlane((int)(ph + 1 < arg_lohi(a, 1)))) { if (xl_) xcd_local_sync(bar); else xcd_barrier(bar); } } ph = __builtin_amdgcn_readfirstlane(ph + 1);
#ifndef GEMM_MASK
#define GEMM_MASK 0xffffffffu
#endif
#define GEMM_RUN(Epi_, E_, A_, Bt_, M_, N_, K_, lda_, ldb_) if constexpr ((GEMM_MASK >> (__COUNTER__ - CNT0)) & 1u) { pg8::Gemm g{(A_), (Bt_)}; pg8::StaticOrder<M_, N_> S; S.init(G, bx); pg8::gemm_phase<Epi_, M_, N_, K_, lda_, ldb_>(WV_, (LAS unsigned char*)lds, g, S, (E_)); }
#define KHAT_RUN(wg_, nwg_, jlo_, jhi_) for (int rep_ = 0; rep_ < REP_KHAT; ++rep_) ph_khat(WV_, (const bf16_t*)(ws + WS_MKV), inp(a, I_XKG) + L * 256, inp(a, I_XQG) + L * 256, (bf16_t*)(ws + WS_MEMN), (wg_), (nwg_), (jlo_), (jhi_));
#define IT_256(n_) (xm ? Items{(bx & 7) * 32 + (bx >> 3), 1, 0} : Items{bx, ((n_) - 1 - bx + G) / G, G})
#define IT_512 (xm ? Items{(bx & 7) * 64 + 2 * (bx >> 3), 2, 1} : Items{bx, (512 - 1 - bx + G) / G, G})
#define IT_M2 (xm ? Items{(bx & 7) * 132 + (bx >> 3), (132 - (bx >> 3) + 31) / 32, 32} : Items{bx, (32 * 33 - 1 - bx + G) / G, G})

    PH_BEGIN
#ifndef SKIP_PRO
        for (int rep_ = 0; rep_ < REP_PRO; ++rep_) ph_prologue(WV_, a, lds);
#endif
    PH_END
    for (int L_ = 0; L_ < DEPTH; ++L_) {
        const int L = __builtin_amdgcn_readfirstlane(L_), j = L >> 1;
#define ODD_PTRS bf16_t* z = (bf16_t*)big; float* gates = (float*)(ws + WS_GATES); bf16_t* kv = (bf16_t*)(ws + WS_KV); float* nloc = (float*)(ws + WS_NLOC); \
            float* mloc = (float*)(ws + WS_MLOC); float* gsum = (float*)(ws + WS_GSUM); float* ms = (float*)(ws + WS_MS); float* ksum = (float*)(ws + WS_KSUM); \
            (void)z; (void)gates; (void)kv; (void)nloc; (void)mloc; (void)gsum; (void)ms; (void)ksum;
        PH_BEGIN {
            if ((L & 1) == 0) { pg8::EpiBf16<1> E{(bf16_t*)big, 1024, 4, (bf16_t*)(big + (size_t)T * 1024 * 2), 512, ssb, -1, nullptr};
                for (int rep_ = 0; rep_ < REP_GIN; ++rep_) GEMM_RUN(pg8::EpiBf16<1>, E, hb, (const bf16_t*)(ws + WS_WEVIN) + (size_t)j * 1536 * 1024, T, 1536, 1024, 1024, 1024)
                if (L == 0) {
                    pg8::EpiBf16<0> E2{(bf16_t*)(ws + WS_MKV), 2048, 1 << 30, nullptr, 0, nullptr, -1, nullptr};
                    pg8::Gemm g2{(const bf16_t*)(ws + WS_MEMN), (const bf16_t*)(ws + WS_WMKV)}; pg8::StaticOrder<BATCH * NMEM, 2048> S2; S2.init(G, (bx + G - (G >> 1)) % G);
                    pg8::gemm_phase<pg8::EpiBf16<0>, BATCH * NMEM, 2048, 1024, 1024, 1024>(WV_, (LAS unsigned char*)lds, g2, S2, E2); }
            } else { ODD_PTRS pg8::EpiBf16<0> E{z, ODD_N, 1 << 30, nullptr, 0, ssb, 14, gates};
                for (int rep_ = 0; rep_ < REP_GIN; ++rep_) GEMM_RUN(pg8::EpiBf16<0>, E, hb, (const bf16_t*)(ws + WS_WODIN) + (size_t)j * ODD_NP * 1024, T, ODD_NP, 1024, 1024, 1024) }
            { const int i0 = ((L & 1) == 0 && L > 0) ? 128 : 192;
              if (G == 256 && bx >= i0) { if (L > 0) { KHAT_RUN((bx - i0) >> 3, (256 - i0) >> 3, 1024 * (bx & 7), 1024 * (bx & 7) + 1024) }
                  if (L + 1 < DEPTH) convert_layer(a, ws, (float*)(lds + WV_ * 16384), olane(), L + 1, 0, (bx - i0) * 8 + WV_, (256 - i0) * 8, conv_share0(L, G)); } }
        } PH_END_XL(L > 0)
        if ((L & 1) == 0) {
            PH_BEGIN {
#ifndef SKIP_S5
                for (int rep_ = 0; rep_ < REP_S5; ++rep_)
                ph_s5(WV_, lds, (const bf16_t*)(big + (size_t)T * 1024 * 2), (bf16_t*)(big + (size_t)T * 1536 * 2), (const float*)(ws + WS_LAMB) + j * 32 * 64 * 2, (const float*)(ws + WS_BBAR) + (size_t)j * 32 * 64 * 16 * 2,
                      inp(a, I_CRE) + (size_t)j * 32 * 16 * 64, inp(a, I_CIM) + (size_t)j * 32 * 16 * 64, inp(a, I_S5D) + j * 512, IT_256(256));
#endif
            } PH_END_XL(true)
            PH_BEGIN { pg8::EpiGlu E{(const bf16_t*)(big + (size_t)T * 1536 * 2), 512, inp(a, I_BGLU) + j * 512, cat, 1024, 512};
                GEMM_RUN(pg8::EpiGlu, E, (const bf16_t*)(big + (size_t)T * 1536 * 2), (const bf16_t*)(ws + WS_WGLU) + (size_t)j * 512 * 512, T, 512, 512, 512, 512)
#ifndef SKIP_GMLP
                { const int sp_ = (bx >> 3) - 16, f_ = (sp_ & 3) + 4 * (16 * (bx & 7) + 4 * (sp_ >> 2));
                  const int wgi = xm ? f_ : ((G > 128) ? bx - 128 : bx), ng = xm ? 4 : ((G > 128) ? G - 128 : G), il = xm ? f_ + 16 : (1 << 30);
                  if (xm ? (bx >= 128) : (wgi >= 0)) for (int rep_ = 0; rep_ < REP_GMLP; ++rep_)
                      ph_gmlp(WV_, lds, (const bf16_t*)big, cat, (const bf16_t*)(ws + WS_GMW) + (size_t)j * 4 * 128 * 128, inp(a, I_GMBS) + j * 512, inp(a, I_GMLN) + j * 512, wgi, ng, il); }
#endif
                if (L == 0 && xm) { KHAT_RUN(bx >> 3, 32, 1024 * (bx & 7), 1024 * (bx & 7) + 1024) }
                if (!xm) { KHAT_RUN(bx, G, 0, BATCH * NMEM * 4) } } PH_END_XL(true)
        } else {
            PH_BEGIN ODD_PTRS {
#ifndef SKIP_MPREP
                ph_moba_prep(WV_, lds, z, inp(a, I_MBQG) + j * 128, inp(a, I_MBKG) + j * 128, ksum, IT_256(256));
#endif
#ifndef SKIP_M1
                for (int rep_ = 0; rep_ < REP_M1; ++rep_)
                ph_mlstm1(WV_, lds, z, gates, inp(a, I_BIF) + j * 8, inp(a, I_CONVW) + (size_t)j * 4 * 1024, inp(a, I_CONVB) + j * 1024, kv, nloc, mloc, gsum, IT_512);
#endif
            } PH_END_XL(true)
            PH_BEGIN ODD_PTRS { ph_mlstm2(WV_, kv, nloc, mloc, gsum, ms, IT_M2); if (G != 256) { KHAT_RUN(bx, G, 0, BATCH * NMEM * 4) } } PH_END_XL(true)
            PH_BEGIN ODD_PTRS {
#ifndef SKIP_M3
                for (int rep_ = 0; rep_ < REP_M3; ++rep_)
                ph_mlstm3(WV_, lds, z, gates, inp(a, I_BIF) + j * 8, inp(a, I_CONVW) + (size_t)j * 4 * 1024, inp(a, I_CONVB) + j * 1024, kv, nloc, ms, inp(a, I_HNG) + j * 512, cat, IT_512);
#endif
#ifndef SKIP_MATTN
                for (int rep_ = 0; rep_ < REP_MATTN; ++rep_)
                ph_moba_attn(WV_, lds, z, ksum, cat, IT_256(256));
#endif
            } PH_END_XL(true)
        }
#define MOE_IDX ((int*)(big + ((size_t)64 << 20)))
#define MOE_GS ((float*)(big + ((size_t)66 << 20)))
#define MOE_RSL ((float*)(big + ((size_t)70 << 20)))
        PH_BEGIN {
            pg8::Unit myu; myu.pm = 8 * (bx & 7) + ((bx >> 3) & 7); myu.pn = (bx >> 6) & 3;
            const bool grp = (G == 256);
            unsigned same = 0u;
            if (grp) { unsigned* ctl = (unsigned*)ws; const unsigned x0 = xb_ld(&ctl[GB_XCC(bx & 63)]), x1 = xb_ld(&ctl[GB_XCC((bx & 63) + 64)]), x2 = xb_ld(&ctl[GB_XCC((bx & 63) + 128)]), x3 = xb_ld(&ctl[GB_XCC((bx & 63) + 192)]);
                same = __builtin_amdgcn_readfirstlane((x0 != 0u && x0 == x1 && x0 == x2 && x0 == x3) ? 1u : 0u); }
#define SEAM(s_) { if (grp) group_sync((unsigned*)ws, myu.pm, (unsigned)(3 * L + (s_)), same); else xcd_barrier(bar); }
            for (int rep_ = 0; rep_ < REP_RES; ++rep_) { pg8::EpiResAddN E{nullptr, hb, ssb + (size_t)T * 16, (rep_ == REP_RES - 1) ? 1.f : 0.f};
                const bf16_t* wout = ((L & 1) == 0) ? (const bf16_t*)(ws + WS_WEVOUT) + (size_t)j * 1024 * 1024 : (const bf16_t*)(ws + WS_WODOUT) + (size_t)j * 1024 * 1024;
                GEMM_RUN(pg8::EpiResAddN, E, cat, wout, T, 1024, 1024, 1024, 1024) }
            SEAM(0)
            { pg8::EpiBf16<0> E{(bf16_t*)big, 1024, 1 << 30, nullptr, 0, ssb + (size_t)T * 16, -1, nullptr};
              GEMM_RUN(pg8::EpiBf16<0>, E, hb, (const bf16_t*)(ws + WS_WXQ) + (size_t)L * 1024 * 1024, T, 1024, 1024, 1024, 1024)
#ifndef SKIP_XATTN
              ph_xattn(WV_, lds, (const bf16_t*)big, (const bf16_t*)(ws + WS_MKV), (const bf16_t*)(ws + WS_MEMN), (bf16_t*)(big + (size_t)T * 1024 * 2), G, bx);
#endif
            }
            SEAM(1)
            for (int rep_ = 0; rep_ < REP_RES; ++rep_) { pg8::EpiResAddN E{nullptr, hb, nullptr, (rep_ == REP_RES - 1) ? 1.f : 0.f};
                GEMM_RUN(pg8::EpiResAddN, E, (const bf16_t*)(big + (size_t)T * 1024 * 2), (const bf16_t*)(ws + WS_WXO) + (size_t)L * 1024 * 1024, T, 1024, 1024, 1024, 1024) }
            SEAM(2)
            for (int rep_ = 0; rep_ < REP_ROUTER; ++rep_) ph_router(WV_, lds, hb, (const bf16_t*)(ws + WS_WRB) + (size_t)L * 2 * 32 * 1024, inp(a, I_BGRP) + L * 4, inp(a, I_BEXP) + L * 16,
                           (int*)(ws + WS_MCNT) + L * 32 + (REP_ROUTER - 1 - rep_) * 128, (rep_ == REP_ROUTER - 1) ? MOE_IDX : (int*)(big + ((size_t)80 << 20)), (rep_ == REP_ROUTER - 1) ? MOE_GS : (float*)(big + ((size_t)82 << 20)), (rep_ == REP_ROUTER - 1) ? MOE_RSL : (float*)(big + ((size_t)86 << 20)),
                           grp ? 4 * myu.pm + myu.pn : bx, grp ? T / 64 : G);
#undef SEAM
        } PH_END
#define MOE_PHASE(UA, UB, DA, DB) { pg8::MoeOrder2 S; S.init(G, bx, (const int*)(ws + WS_MCNT) + L * 32, olane(), (LAS unsigned char*)lds); const int Rt = S.mtot; (void)Rt; S.range(UA, UB, DA, DB); \
            BselMoe2 bs{(const bf16_t*)(ws + WS_WUP) + (size_t)(L * 2) * 4096 * 1024, (const bf16_t*)(ws + WS_WDN) + (size_t)L * 1024 * 4096}; \
            pg8::EpiMoeUpP EU{(bf16_t*)big, MOE_GS, MOE_RSL}; pg8::EpiMoeDownP ED{(L == DEPTH - 1) ? h : (float*)nullptr, MOE_IDX, hb, ssb}; \
            pg8::gemm_phase_moe2<pg8::EpiMoeUpP, pg8::EpiMoeDownP>(WV_, (LAS unsigned char*)lds, hb, (const bf16_t*)big, MOE_IDX, S, bs, EU, ED); }
        PH_BEGIN MOE_PHASE(0, 64, 0, 0) PH_END
#define MOE_CONV_SPLIT pg8::MoeOrder2 S2; S2.init(G, bx, (const int*)(ws + WS_MCNT) + L * 32, olane(), (LAS unsigned char*)lds); const int nu = (S2.mtot - 64) * 4, wB = 2 * (G - nu), wC = 3 * (G - 2 * nu); \
            const int n0 = conv_share0(L, G); const int n1 = n0 + ((wC > 0) ? ((wc::layer_items(L + 1) - n0) * wB) / (wB + wC) : wc::layer_items(L + 1) - n0); (void)n1;
        PH_BEGIN { MOE_PHASE(64, Rt, 0, 128 - Rt)
            if (L + 1 < DEPTH) { MOE_CONV_SPLIT
                if (S2.c >= nu) convert_layer(a, ws, (float*)(lds + WV_ * 16384), olane(), L + 1, n0, (S2.c - nu) * 8 + WV_, (G - nu) * 8, n1); } } PH_END
        PH_BEGIN { MOE_PHASE(0, 0, 128 - Rt, Rt)
            if (L + 1 < DEPTH) { MOE_CONV_SPLIT
                if (S2.c >= 2 * nu) convert_layer(a, ws, (float*)(lds + WV_ * 16384), olane(), L + 1, n1, (S2.c - 2 * nu) * 8 + WV_, (G - 2 * nu) * 8); } } PH_END
    }
#undef PH_BEGIN
#undef PH_END
}

constexpr int NPH = 1 + 2 * (3 + 1 + 3) + 2 * (4 + 1 + 3);

extern "C" void kernel_launch(void* const* d_in, const int* in_sizes, int n_in, void* d_out, int out_size, void* d_ws, size_t ws_size, hipStream_t stream) {
    static int grid = 0;
    if (grid == 0) {
        if (n_in != 41 || out_size != T * D || ws_size < WS_END) { fprintf(stderr, "kernel_launch: unexpected shapes (n_in %d out %d ws %zu need %zu)\n", n_in, out_size, ws_size, (size_t)WS_END); grid = -1; return; }
        int dev = 0, cus = 0, per_cu = 0;
        if (hipGetDevice(&dev) != hipSuccess || hipDeviceGetAttribute(&cus, hipDeviceAttributeMultiprocessorCount, dev) != hipSuccess) { grid = -1; return; }
        if (hipFuncSetAttribute((const void*)hybrid_fwd, hipFuncAttributeMaxDynamicSharedMemorySize, LDS_BYTES) != hipSuccess) { fprintf(stderr, "kernel_launch: hipFuncSetAttribute failed\n"); grid = -1; return; }
        if (hipOccupancyMaxActiveBlocksPerMultiprocessor(&per_cu, (const void*)hybrid_fwd, NTHR, LDS_BYTES) != hipSuccess || per_cu < 1) { fprintf(stderr, "kernel_launch: occupancy query says %d\n", per_cu); }
        (void)hipGetLastError();
        grid = cus;
    }
    if (grid < 0) return;
    (void)hipMemsetAsync((char*)d_ws + WS_CTL, 0, CTL_BYTES, stream);
    Args a{};
    for (int i = 0; i < 41; ++i) a.in[i] = (const float*)d_in[i];
    a.out = (float*)d_out; a.ws = (unsigned char*)d_ws;
#if MK_PER_PHASE
    for (int p = 0; p < NPH; ++p) { a.lo = p; a.hi = p + 1; hipLaunchKernelGGL(hybrid_fwd, dim3(grid), dim3(NTHR), LDS_BYTES, stream, a); }
#else
    a.lo = 0; a.hi = NPH; hipLaunchKernelGGL(hybrid_fwd, dim3(grid), dim3(NTHR), LDS_BYTES, stream, a);
#endif
}
```
